# Optimizing an MI355X kernel written in HIP

```python
import math
import jax
import jax.numpy as jnp
from jax import lax
import numpy as np

D_MODEL = 2048
BATCH = 2
SEQ = 4096
DEPTH = 4

D_MIX = D_MODEL
GLA_HEADS = 4
GLA_DV = 3 * D_MIX // 8
GLA_DK = GLA_DV // 2
GLA_HD_K = GLA_DK // GLA_HEADS
GLA_HD_V = GLA_DV // GLA_HEADS
GLA_RANK = 16
GLA_TAU = 16.0
GLA_CHUNK = 64
DIL_HEADS = 6
DIL_HD = 128
DIL_DIM = DIL_HEADS * DIL_HD
DIL_BRANCHES = ((128, 1), (512, 4), (2048, 16))
DIL_QBLOCK = 128
CONV_C = D_MIX - GLA_DV - DIL_DIM
CONV_K = 31
D_FF = 5504
IN_SIZES = (GLA_DK, GLA_DK, GLA_DV, GLA_RANK, GLA_RANK, GLA_DV,
            DIL_DIM, DIL_DIM, DIL_DIM, 2 * CONV_C)
N_IN = sum(IN_SIZES)
DEEPNORM_ALPHA = (2.0 * DEPTH) ** 0.25
DEEPNORM_BETA = (8.0 * DEPTH) ** -0.25
LN_EPS = 1e-5

kernel_name = 'hymba_style_bidir_gla_dilated_conformer_deepnorm'


def layer_norm(x, g, b):
    xf = x.astype(jnp.float32)
    mu = jnp.mean(xf, axis=-1, keepdims=True)
    var = jnp.mean(jnp.square(xf - mu), axis=-1, keepdims=True)
    return ((xf - mu) * lax.rsqrt(var + LN_EPS) * g + b).astype(x.dtype)


def swiglu(h, w_gate, w_up, w_down):
    return (jax.nn.silu(h @ w_gate) * (h @ w_up)) @ w_down


def gla_scan(q, k, v, log_a):
    B, T, H, K = q.shape
    V = v.shape[-1]
    C = GLA_CHUNK
    N = T // C
    qc = q.astype(jnp.float32).reshape(B, N, C, H, K)
    kc = k.astype(jnp.float32).reshape(B, N, C, H, K)
    vc = v.astype(jnp.float32).reshape(B, N, C, H, V)
    b = jnp.cumsum(log_a.reshape(B, N, C, H, K), axis=2)
    b_end = b[:, :, -1]
    q_dec = qc * jnp.exp(b)
    k_inv = kc * jnp.exp(-b)
    k_end = kc * jnp.exp(b_end[:, :, None] - b)
    causal = jnp.tril(jnp.ones((C, C), dtype=bool))
    att = jnp.einsum('bnchk,bnshk->bnhcs', q_dec, k_inv)
    att = jnp.where(causal, att, 0.0)
    o_intra = jnp.einsum('bnhcs,bnshv->bnchv', att, vc)
    u = jnp.einsum('bnshk,bnshv->bnhkv', k_end, vc)

    def step(S, xs):
        dec, un = xs
        return dec[..., None] * S + un, S

    S0 = jnp.zeros((B, H, K, V), jnp.float32)
    _, S_prev = lax.scan(step, S0, (jnp.exp(b_end).transpose(1, 0, 2, 3),
                                    u.transpose(1, 0, 2, 3, 4)))
    S_prev = S_prev.transpose(1, 0, 2, 3, 4)
    o_inter = jnp.einsum('bnchk,bnhkv->bnchv', q_dec, S_prev)
    return (o_intra + o_inter).reshape(B, T, H, V)


def dilated_attention(q, k, v):
    B, T, H, E = q.shape
    offs = np.stack([d * np.arange(-((w // 2) // d), (w // 2) // d + 1)
                     for (w, d) in DIL_BRANCHES])
    slopes = 2.0 ** (-8.0 * np.arange(1, H + 1) / H)
    alibi = jnp.asarray(-slopes[:, None, None] * np.abs(offs)[None], jnp.float32)
    offs_j = jnp.asarray(offs, jnp.int32)
    scale = E ** -0.5

    def block(i):
        t0 = i * DIL_QBLOCK
        qb = lax.dynamic_slice_in_dim(q, t0, DIL_QBLOCK, axis=1)
        pos = t0 + jnp.arange(DIL_QBLOCK)[:, None, None] + offs_j[None]
        valid = (pos >= 0) & (pos < T)
        pc = jnp.clip(pos, 0, T - 1)
        kg = jnp.take(k, pc, axis=1)
        vg = jnp.take(v, pc, axis=1)
        s = jnp.einsum('bqhe,bqnjhe->bhqnj', qb, kg,
                       preferred_element_type=jnp.float32) * scale + alibi[:, None]
        s = jnp.where(valid[None, None], s, -1e30)
        m = jnp.max(s, axis=-1, keepdims=True)
        p = jnp.exp(s - m)
        z = jnp.sum(p, axis=-1, keepdims=True)
        o = jnp.einsum('bhqnj,bqnjhe->bqnhe', p / z, vg.astype(jnp.float32))
        lse = (m + jnp.log(z))[..., 0]
        wts = jax.nn.softmax(lse, axis=-1)
        return jnp.einsum('bhqn,bqnhe->bqhe', wts, o)

    out = lax.map(block, jnp.arange(T // DIL_QBLOCK))
    return out.transpose(1, 0, 2, 3, 4).reshape(B, T, H, E)


def hybrid_mixer(h, w_in, dec_w_f, dec_b_f, dec_w_b, dec_b_b, gla_norm_g,
                 conv_w, conv_b, conv_ln_g, conv_ln_b, w_out):
    B, T, _ = h.shape
    proj = h @ w_in
    idx = [int(c) for c in np.cumsum(IN_SIZES)[:-1]]
    gq, gk, gv, rf, rb, gg, dq, dk, dv, cv = jnp.split(proj, idx, axis=-1)

    q = gq.reshape(B, T, GLA_HEADS, GLA_HD_K) * (GLA_HD_K ** -0.5)
    k = gk.reshape(B, T, GLA_HEADS, GLA_HD_K)
    v = gv.reshape(B, T, GLA_HEADS, GLA_HD_V)
    la_f = (jax.nn.log_sigmoid((rf @ dec_w_f + dec_b_f).astype(jnp.float32)) / GLA_TAU
            ).reshape(B, T, GLA_HEADS, GLA_HD_K)
    la_b = (jax.nn.log_sigmoid((rb @ dec_w_b + dec_b_b).astype(jnp.float32)) / GLA_TAU
            ).reshape(B, T, GLA_HEADS, GLA_HD_K)
    o_f = gla_scan(q, k, v, la_f)
    o_b = jnp.flip(gla_scan(jnp.flip(q, 1), jnp.flip(k, 1), jnp.flip(v, 1),
                            jnp.flip(la_b, 1)), 1)
    o = o_f + o_b
    o = o * lax.rsqrt(jnp.mean(jnp.square(o), axis=-1, keepdims=True) + LN_EPS)
    o = o.reshape(B, T, GLA_DV) * gla_norm_g
    gla_out = (o * jax.nn.silu(gg.astype(jnp.float32))).astype(h.dtype)

    dil_out = dilated_attention(dq.reshape(B, T, DIL_HEADS, DIL_HD),
                                dk.reshape(B, T, DIL_HEADS, DIL_HD),
                                dv.reshape(B, T, DIL_HEADS, DIL_HD))
    dil_out = dil_out.reshape(B, T, DIL_DIM).astype(h.dtype)

    c_val, c_gate = jnp.split(cv, 2, axis=-1)
    u = c_val * jax.nn.sigmoid(c_gate)
    y = lax.conv_general_dilated(u, conv_w[:, None, :], window_strides=(1,),
                                 padding=[(CONV_K // 2, CONV_K // 2)],
                                 dimension_numbers=('NWC', 'WIO', 'NWC'),
                                 feature_group_count=CONV_C) + conv_b
    conv_out = jax.nn.silu(layer_norm(y, conv_ln_g, conv_ln_b))

    cat = jnp.concatenate([gla_out, dil_out, conv_out], axis=-1)
    return cat @ w_out


def setup_inputs(seed: int = 0) -> dict:
    key = jax.random.key(seed)
    ks = jax.random.split(key, 32)
    L, D, F = DEPTH, D_MODEL, D_FF

    def nrm(k, shape, scale):
        return jax.random.normal(k, shape, jnp.float32) * scale

    return {
        'x': nrm(ks[0], (BATCH, SEQ, D), 1.0),
        'ffn1_w_gate': nrm(ks[1], (L, D, F), D ** -0.5),
        'ffn1_w_up': nrm(ks[2], (L, D, F), D ** -0.5),
        'ffn1_w_down': nrm(ks[3], (L, F, D), DEEPNORM_BETA * F ** -0.5),
        'ln1_g': 1.0 + nrm(ks[4], (L, D), 0.02),
        'ln1_b': nrm(ks[5], (L, D), 0.02),
        'w_in': nrm(ks[6], (L, D, N_IN), D ** -0.5),
        'gla_decay_w_fwd': nrm(ks[7], (L, GLA_RANK, GLA_DK), GLA_RANK ** -0.5),
        'gla_decay_b_fwd': nrm(ks[8], (L, GLA_DK), 0.1),
        'gla_decay_w_bwd': nrm(ks[9], (L, GLA_RANK, GLA_DK), GLA_RANK ** -0.5),
        'gla_decay_b_bwd': nrm(ks[10], (L, GLA_DK), 0.1),
        'gla_norm_g': 1.0 + nrm(ks[11], (L, GLA_DV), 0.02),
        'conv_w': nrm(ks[12], (L, CONV_K, CONV_C), CONV_K ** -0.5),
        'conv_b': nrm(ks[13], (L, CONV_C), 0.02),
        'conv_ln_g': 1.0 + nrm(ks[14], (L, CONV_C), 0.02),
        'conv_ln_b': nrm(ks[15], (L, CONV_C), 0.02),
        'w_out': nrm(ks[16], (L, D_MIX, D), DEEPNORM_BETA * D_MIX ** -0.5),
        'ln2_g': 1.0 + nrm(ks[17], (L, D), 0.02),
        'ln2_b': nrm(ks[18], (L, D), 0.02),
        'ffn2_w_gate': nrm(ks[19], (L, D, F), D ** -0.5),
        'ffn2_w_up': nrm(ks[20], (L, D, F), D ** -0.5),
        'ffn2_w_down': nrm(ks[21], (L, F, D), DEEPNORM_BETA * F ** -0.5),
        'ln3_g': 1.0 + nrm(ks[22], (L, D), 0.02),
        'ln3_b': nrm(ks[23], (L, D), 0.02),
    }


def reference(x, ffn1_w_gate, ffn1_w_up, ffn1_w_down, ln1_g, ln1_b, w_in,
              gla_decay_w_fwd, gla_decay_b_fwd, gla_decay_w_bwd, gla_decay_b_bwd,
              gla_norm_g, conv_w, conv_b, conv_ln_g, conv_ln_b, w_out, ln2_g, ln2_b,
              ffn2_w_gate, ffn2_w_up, ffn2_w_down, ln3_g, ln3_b):
    for l in range(DEPTH):
        x = layer_norm(DEEPNORM_ALPHA * x
                       + 0.5 * swiglu(x, ffn1_w_gate[l], ffn1_w_up[l], ffn1_w_down[l]),
                       ln1_g[l], ln1_b[l])
        mix = hybrid_mixer(x, w_in[l], gla_decay_w_fwd[l], gla_decay_b_fwd[l],
                           gla_decay_w_bwd[l], gla_decay_b_bwd[l], gla_norm_g[l],
                           conv_w[l], conv_b[l], conv_ln_g[l], conv_ln_b[l], w_out[l])
        x = layer_norm(DEEPNORM_ALPHA * x + mix, ln2_g[l], ln2_b[l])
        x = layer_norm(DEEPNORM_ALPHA * x
                       + 0.5 * swiglu(x, ffn2_w_gate[l], ffn2_w_up[l], ffn2_w_down[l]),
                       ln3_g[l], ln3_b[l])
    return x
```

```cpp
#include <hip/hip_runtime.h>
#include <cstdio>
#include <cstdint>
namespace pg8 {
#define PG8_LAS __attribute__((address_space(3)))
typedef unsigned short bf16_t;
typedef short bf16x8 __attribute__((ext_vector_type(8)));
typedef float f32x4 __attribute__((ext_vector_type(4)));
typedef unsigned u32x4 __attribute__((ext_vector_type(4)));
constexpr int BM = 256, BK = 64, HALF = 128, HTB = HALF * BK * 2  , STAGE_BYTES = 8 * HTB, NXCD = 8, WGM = 8;

__host__ __device__ __forceinline__ int lds_byte(int r, int c) { const int st = (r >> 4) * 2 + (c >> 5), rr = r & 15, cc = c & 31, ob = rr * 64 + cc * 2; return st * 1024 + (ob ^ (((ob >> 9) & 1) << 5)); }
__host__ __device__ __forceinline__ void stage_rc(int b, int& R, int& C) { const int st = b / 1024, sb = b % 1024, swz = sb ^ (((sb >> 9) & 1) << 5); R = (st >> 1) * 16 + swz / 64; C = (st & 1) * 32 + (swz % 64) / 2; }
__host__ __device__ __forceinline__ int perm32(int rho) { const int n = rho >> 4, i = rho & 15; return 8 * (i >> 2) + 4 * n + (i & 3); }

struct Unit { int pm, pn; };
struct Gemm { const bf16_t* A; const bf16_t* Bt; int M, N, K; };

struct StaticOrder {
    int nM, nN, nwg, G, c;
    __host__ __device__ void init(int M, int N, int G_, int c_) { nM = M / BM; nN = N / BM; nwg = nM * nN; G = G_; c = c_; }
    __host__ __device__ bool next(int i, Unit& u) const {
        const long L = (long)i * G + c; if (L >= nwg) return false;
        int wgid = (int)L; { const int q = nwg / NXCD, r = nwg % NXCD, xcd = wgid % NXCD, off = wgid / NXCD; wgid = (xcd < r ? xcd * (q + 1) : r * (q + 1) + (xcd - r) * q) + off; }
        const int nig = WGM * nN, gid = wgid / nig, fm = gid * WGM, gsz = (nM - fm) < WGM ? (nM - fm) : WGM;
        u.pm = fm + ((wgid % nig) % gsz); u.pn = (wgid % nig) / gsz; return true;
    }
    __device__ __forceinline__ void a_ready(const Unit&) const {}
    __device__ __forceinline__ void done(const Unit&) const {}
};

template <class Epi, class Sched, bool ALIGN_EPI = false, bool SP2 = false>
__device__ __forceinline__ void gemm_phase(PG8_LAS unsigned char* lds, const Gemm g, const Sched& S, const Epi& E) {
    int tid_l = threadIdx.x; asm volatile("" : "+v"(tid_l));
    const int tid = tid_l, wid = __builtin_amdgcn_readfirstlane(tid >> 6), lane = tid & 63, wr = wid >> 2, wc = wid & 3, fr = lane & 15, fq = lane >> 4;
    const int K = g.K, nt = K / BK;
    unsigned voffA[2], voffB[2];
#pragma unroll
    for (int i = 0; i < 2; ++i) { int R, C; stage_rc(tid * 16 + i * 8192, R, C); const int Rb = Epi::PERM ? ((R & ~31) + perm32(R & 31)) : R;
        voffA[i] = (unsigned)(R * K + C) * 2u; voffB[i] = (unsigned)(Rb * K + C) * 2u; }
    const size_t kstep = (size_t)(BK * 2);
    const size_t hstep = (size_t)HALF * K * 2;
    const size_t tstep = 2 * hstep;
    const unsigned ldsw = (unsigned)wid * 1024u;
    const int aoff = lds_byte(wr * 64 + fr, fq * 8), boff = lds_byte(wc * 32 + fr, fq * 8);
#define PG8_SA(b, h) (((b) * 2 + (h)) * HTB)
#define PG8_SB(b, h) ((4 + (b) * 2 + (h)) * HTB)
#define PG8_STAGE(bufoff, gbase, voff) do { _Pragma("unroll") for (int _i = 0; _i < 2; ++_i) \
        __builtin_amdgcn_global_load_lds((const unsigned*)((const char*)(gbase) + (voff)[_i]), (PG8_LAS unsigned*)(lds + (bufoff) + ldsw + _i * 8192), 16, 0, 0); } while (0)
#define PG8_LDA(dst, b, h) do { _Pragma("unroll") for (int m = 0; m < 4; ++m) _Pragma("unroll") for (int k = 0; k < 2; ++k) dst[m][k] = *(const PG8_LAS bf16x8*)(lds + PG8_SA(b, h) + aoff + m * 2048 + k * 1024); } while (0)
#define PG8_LDB(dst, b, h) do { _Pragma("unroll") for (int n = 0; n < 2; ++n) _Pragma("unroll") for (int k = 0; k < 2; ++k) dst[n][k] = *(const PG8_LAS bf16x8*)(lds + PG8_SB(b, h) + boff + n * 2048 + k * 1024); } while (0)
#define PG8_MMA(ai, bj, At, Bt) do { __builtin_amdgcn_s_setprio(1); _Pragma("unroll") for (int m = 0; m < 4; ++m) _Pragma("unroll") for (int n = 0; n < 2; ++n) _Pragma("unroll") for (int k = 0; k < 2; ++k) \
        acc[ai][bj][m][n] = __builtin_amdgcn_mfma_f32_16x16x32_bf16(Bt[n][k], At[m][k], acc[ai][bj][m][n], 0, 0, 0); __builtin_amdgcn_s_setprio(0); } while (0)
#define PG8_WAIT_V(n) asm volatile("s_waitcnt vmcnt(" #n ")" ::: "memory")
#define PG8_WAIT_L(n) asm volatile("s_waitcnt lgkmcnt(" #n ")" ::: "memory")
#define PG8_BAR __builtin_amdgcn_s_barrier()
#define PG8_SCHED __builtin_amdgcn_sched_barrier(0)
    Unit cur, nxt; int ui = 0;
    if (!S.next(0, cur)) return;
    f32x4 acc[2][2][4][2];
#pragma unroll
    for (int a = 0; a < 2; ++a)
#pragma unroll
        for (int b = 0; b < 2; ++b)
#pragma unroll
            for (int m = 0; m < 4; ++m)
#pragma unroll
                for (int n = 0; n < 2; ++n) acc[a][b][m][n] = (f32x4){0.f, 0.f, 0.f, 0.f};
    bf16x8 At[4][2], B0[2][2], B1[2][2];
    const char* cA = (const char*)g.A + (size_t)cur.pm * tstep; const char* cB = (const char*)g.Bt + (size_t)cur.pn * tstep;
    S.a_ready(cur);
    if constexpr (SP2) {
        PG8_STAGE(PG8_SB(0, 0), cB, voffB); PG8_STAGE(PG8_SB(0, 1), cB + hstep, voffB); PG8_STAGE(PG8_SA(0, 0), cA, voffA); PG8_STAGE(PG8_SA(0, 1), cA + hstep, voffA);
        if (wr == 1) PG8_BAR;
        PG8_WAIT_V(2); PG8_BAR;
        PG8_STAGE(PG8_SB(1, 0), cB + kstep, voffB); PG8_STAGE(PG8_SA(1, 0), cA + kstep, voffA); PG8_STAGE(PG8_SB(1, 1), cB + hstep + kstep, voffB);
        PG8_WAIT_V(6); PG8_BAR;
    } else {
        PG8_STAGE(PG8_SB(0, 0), cB, voffB); PG8_STAGE(PG8_SA(0, 0), cA, voffA); PG8_STAGE(PG8_SB(0, 1), cB + hstep, voffB); PG8_STAGE(PG8_SA(0, 1), cA + hstep, voffA);
        if (wr == 1) PG8_BAR;
        PG8_WAIT_V(4); PG8_BAR;
        PG8_STAGE(PG8_SB(1, 0), cB + kstep, voffB); PG8_STAGE(PG8_SA(1, 0), cA + kstep, voffA); PG8_STAGE(PG8_SB(1, 1), cB + hstep + kstep, voffB);
        PG8_WAIT_V(6); PG8_BAR;
    }
    for (;;) {
        const bool has_next = S.next(ui + 1, nxt);
        const char* nA = has_next ? (const char*)g.A + (size_t)nxt.pm * tstep : cA; const char* nB = has_next ? (const char*)g.Bt + (size_t)nxt.pn * tstep : cB;
        for (int t = 0; t < nt; t += 2) {
            const bool last = (t == nt - 2);
            const char* a1 = cA + (size_t)(t + 1) * kstep;
            const char* a2 = last ? nA : cA + (size_t)(t + 2) * kstep; const char* b2 = last ? nB : cB + (size_t)(t + 2) * kstep;
            const char* a3 = a2 + kstep; const char* b3 = b2 + kstep;
            if (last && has_next) S.a_ready(nxt);
            if constexpr (SP2) {
            PG8_LDB(B0, 0, 0); PG8_LDB(B1, 0, 1); PG8_SCHED; PG8_LDA(At, 0, 0); PG8_STAGE(PG8_SA(1, 1), a1 + hstep, voffA);
            PG8_WAIT_V(8); PG8_WAIT_L(0); PG8_BAR; PG8_MMA(0, 0, At, B0); PG8_MMA(0, 1, At, B1); PG8_BAR; PG8_SCHED;
            PG8_LDA(At, 0, 1); PG8_STAGE(PG8_SB(0, 0), b2, voffB); PG8_STAGE(PG8_SB(0, 1), b2 + hstep, voffB); PG8_STAGE(PG8_SA(0, 0), a2, voffA);
            PG8_WAIT_V(8); PG8_WAIT_L(0); PG8_BAR; PG8_MMA(1, 0, At, B0); PG8_MMA(1, 1, At, B1); PG8_BAR; PG8_SCHED;
            PG8_LDB(B0, 1, 0); PG8_LDB(B1, 1, 1); PG8_SCHED; PG8_LDA(At, 1, 0); PG8_STAGE(PG8_SA(0, 1), a2 + hstep, voffA);
            PG8_WAIT_V(8); PG8_WAIT_L(0); PG8_BAR; PG8_MMA(0, 0, At, B0); PG8_MMA(0, 1, At, B1); PG8_BAR; PG8_SCHED;
            PG8_LDA(At, 1, 1); PG8_STAGE(PG8_SB(1, 0), b3, voffB); PG8_STAGE(PG8_SB(1, 1), b3 + hstep, voffB); PG8_STAGE(PG8_SA(1, 0), a3, voffA);
            PG8_WAIT_V(8); PG8_WAIT_L(0); PG8_BAR; PG8_MMA(1, 0, At, B0); PG8_MMA(1, 1, At, B1); PG8_BAR; PG8_SCHED;
            } else {
            PG8_LDB(B0, 0, 0); PG8_SCHED; PG8_LDA(At, 0, 0); PG8_STAGE(PG8_SA(1, 1), a1 + hstep, voffA);
            PG8_WAIT_L(8); PG8_BAR; PG8_WAIT_L(0); PG8_MMA(0, 0, At, B0); PG8_BAR; PG8_SCHED;
            PG8_LDB(B1, 0, 1); PG8_STAGE(PG8_SB(0, 0), b2, voffB);
            PG8_BAR; PG8_WAIT_L(0); PG8_MMA(0, 1, At, B1); PG8_BAR;
            PG8_LDA(At, 0, 1); PG8_STAGE(PG8_SA(0, 0), a2, voffA);
            PG8_BAR; PG8_WAIT_L(0); PG8_MMA(1, 0, At, B0); PG8_BAR; PG8_SCHED;
            PG8_STAGE(PG8_SB(0, 1), b2 + hstep, voffB);
            PG8_WAIT_V(6); PG8_BAR; PG8_MMA(1, 1, At, B1); PG8_BAR;
            PG8_LDB(B0, 1, 0); PG8_SCHED; PG8_LDA(At, 1, 0); PG8_STAGE(PG8_SA(0, 1), a2 + hstep, voffA);
            PG8_WAIT_L(8); PG8_BAR; PG8_WAIT_L(0); PG8_MMA(0, 0, At, B0); PG8_BAR; PG8_SCHED;
            PG8_LDB(B1, 1, 1); PG8_STAGE(PG8_SB(1, 0), b3, voffB);
            PG8_BAR; PG8_WAIT_L(0); PG8_MMA(0, 1, At, B1); PG8_BAR;
            PG8_LDA(At, 1, 1); PG8_STAGE(PG8_SA(1, 0), a3, voffA);
            PG8_BAR; PG8_WAIT_L(0); PG8_MMA(1, 0, At, B0); PG8_BAR; PG8_SCHED;
            PG8_STAGE(PG8_SB(1, 1), b3 + hstep, voffB);
            PG8_WAIT_V(6); PG8_BAR; PG8_MMA(1, 1, At, B1); PG8_BAR;
            }
        }
        if constexpr (ALIGN_EPI) { if (wr == 0) PG8_BAR; }
        if constexpr (!Epi::AFTER_DRAIN) { E(acc, cur, wr, wc, fr, fq); S.done(cur); }
        if (!has_next) break;
#pragma unroll
        for (int a = 0; a < 2; ++a)
#pragma unroll
            for (int b = 0; b < 2; ++b)
#pragma unroll
                for (int m = 0; m < 4; ++m)
#pragma unroll
                    for (int n = 0; n < 2; ++n) acc[a][b][m][n] = (f32x4){0.f, 0.f, 0.f, 0.f};
        cur = nxt; cA = nA; cB = nB; ++ui;
        if constexpr (ALIGN_EPI) { if (wr == 1) PG8_BAR; }
    }
    PG8_WAIT_V(0);
    if constexpr (!ALIGN_EPI) { if (wr == 0) PG8_BAR; }
    PG8_BAR;
    if constexpr (Epi::AFTER_DRAIN) { E.fused(acc, cur, wr, wc, fr, fq, lds, wid, lane); S.done(cur); }
#undef PG8_SA
#undef PG8_SB
#undef PG8_STAGE
#undef PG8_LDA
#undef PG8_LDB
#undef PG8_MMA
#undef PG8_WAIT_V
#undef PG8_WAIT_L
#undef PG8_BAR
#undef PG8_SCHED
}
}
namespace pg8 {
__device__ __forceinline__ unsigned cvt_pk_bf16(float lo, float hi) { unsigned r; asm volatile("v_cvt_pk_bf16_f32 %0, %1, %2" : "=v"(r) : "v"(lo), "v"(hi)); return r; }
struct EpiBf16 {
    static constexpr bool PERM = true, AFTER_DRAIN = false;
    bf16_t* O; int ldc;
    __device__ __forceinline__ void operator()(const f32x4 (&acc)[2][2][4][2], const Unit& u, int wr, int wc, int fr, int fq) const {
        const int row0 = u.pm * BM + wr * 64 + fr; const int col0 = u.pn * BM + wc * 32 + 8 * fq;
#pragma unroll
        for (int ai = 0; ai < 2; ++ai)
#pragma unroll
            for (int m = 0; m < 4; ++m) { bf16_t* rowp = O + (size_t)(row0 + ai * HALF + m * 16) * ldc + col0;
#pragma unroll
                for (int bj = 0; bj < 2; ++bj) { const f32x4 v0 = acc[ai][bj][m][0], v1 = acc[ai][bj][m][1];
                    u32x4 w; w.x = cvt_pk_bf16(v0[0], v0[1]); w.y = cvt_pk_bf16(v0[2], v0[3]); w.z = cvt_pk_bf16(v1[0], v1[1]); w.w = cvt_pk_bf16(v1[2], v1[3]);
                    *(u32x4*)(rowp + bj * HALF) = w; } }
    }
};
struct EpiSwiglu {
    static constexpr bool PERM = true, AFTER_DRAIN = false;
    bf16_t* O; int ldc;
    __device__ __forceinline__ void operator()(const f32x4 (&acc)[2][2][4][2], const Unit& u, int wr, int wc, int fr, int fq) const {
        const int row0 = u.pm * BM + wr * 64 + fr; const int col0 = u.pn * HALF + wc * 32 + 8 * fq;
#pragma unroll
        for (int ai = 0; ai < 2; ++ai)
#pragma unroll
            for (int m = 0; m < 4; ++m) { bf16_t* rowp = O + (size_t)(row0 + ai * HALF + m * 16) * ldc + col0;
                float h[8];
#pragma unroll
                for (int n = 0; n < 2; ++n)
#pragma unroll
                    for (int j = 0; j < 4; ++j) { const float g = acc[ai][0][m][n][j], up = acc[ai][1][m][n][j];
                        h[n * 4 + j] = g * __builtin_amdgcn_rcpf(1.0f + __expf(-g)) * up; }
                u32x4 w; w.x = cvt_pk_bf16(h[0], h[1]); w.y = cvt_pk_bf16(h[2], h[3]); w.z = cvt_pk_bf16(h[4], h[5]); w.w = cvt_pk_bf16(h[6], h[7]);
                *(u32x4*)rowp = w; }
    }
};
struct EpiResid {
    static constexpr bool PERM = false, AFTER_DRAIN = false;
    const float* base; float* Z; int ldc; float alpha, beta;
    __device__ __forceinline__ void operator()(const f32x4 (&acc)[2][2][4][2], const Unit& u, int wr, int wc, int fr, int fq) const {
        const int row0 = u.pm * BM + wr * 64 + fr, col0 = u.pn * BM + wc * 32 + 4 * fq;
#pragma unroll
        for (int ai = 0; ai < 2; ++ai)
#pragma unroll
            for (int m = 0; m < 4; ++m) { const size_t off = (size_t)(row0 + ai * HALF + m * 16) * ldc + col0;
#pragma unroll
                for (int bj = 0; bj < 2; ++bj)
#pragma unroll
                    for (int n = 0; n < 2; ++n) { const f32x4 bs = *(const f32x4*)(base + off + bj * HALF + n * 16);
                        *(f32x4*)(Z + off + bj * HALF + n * 16) = bs * alpha + acc[ai][bj][m][n] * beta; } }
    }
};
}
constexpr int BATCH = 2, T = 4096, D = 2048, DEPTH = 4, M = BATCH * T;
constexpr int FF = 5504, NGU = 2 * FF;
constexpr int NIN = 5664, NINP = 5888;
constexpr int GH = 4, GK = 96, GV = 192, GDK = 384, GDV = 768, GR = 16, GC = 64, NCH = T / GC;
constexpr int DH = 6, DE = 128, DD = 768;
constexpr int CC = 512, CK = 31;
constexpr int PC_GQ = 0, PC_GK = 384, PC_GV = 768, PC_GG = 1536, PC_DQ = 2304, PC_DK = 3072, PC_DV = 3840, PC_CVAL = 4608, PC_CGATE = 5120, PC_RF = 5632, PC_RB = 5648;
constexpr float LN_EPS = 1e-5f;
constexpr float DN_ALPHA = 1.6817928305074290f;
constexpr size_t MiB = 1u << 20;
constexpr size_t WS_CTL = 0, CTL_ZERO_BYTES = 65536;
constexpr size_t WS_W = 1 * MiB;
constexpr size_t WO_GU1 = 0, WO_D1 = 43 * MiB, WO_IN = WO_D1 + 43 * MiB / 2, WO_OUT = WO_IN + 23 * MiB, WO_GU2 = WO_OUT + 8 * MiB, WO_D2 = WO_GU2 + 43 * MiB, W_LAYER = WO_D2 + 43 * MiB / 2;
static_assert(W_LAYER == 160 * MiB, "weights per layer");
constexpr size_t WS_XF = WS_W + W_LAYER;
constexpr size_t WS_Z = WS_XF + 64 * MiB;
constexpr size_t WS_XB = WS_Z + 64 * MiB;
constexpr size_t WS_CAT = WS_XB + 32 * MiB;
constexpr size_t WS_HP = WS_CAT + 32 * MiB;
constexpr size_t WS_U = WS_HP + 92 * MiB;
constexpr size_t WS_LAF = WS_U + 72 * MiB;
constexpr size_t WS_LAB = WS_LAF + 12 * MiB;
constexpr size_t WS_DEC = WS_LAB + 12 * MiB;
constexpr size_t WS_OP = WS_DEC + 1 * MiB;
constexpr size_t WS_LSE = WS_OP + 72 * MiB;
constexpr size_t WS_END = WS_LSE + 1 * MiB;
static_assert(WS_END <= 700 * MiB, "workspace");
constexpr int CW_BAR = 1024;
constexpr int RING_BYTES = 131072, MISC_OFF = RING_BYTES + 320, LDS_BYTES = 147456;
constexpr int NWAVES = 8, NTHR = 512;

#define GAS __attribute__((address_space(1)))
#define LAS __attribute__((address_space(3)))
typedef unsigned short bf16;
typedef unsigned v4u __attribute__((ext_vector_type(4)));
typedef unsigned v2u __attribute__((ext_vector_type(2)));
typedef float f32x4 __attribute__((ext_vector_type(4)));
#define LDS_WAIT() asm volatile("s_waitcnt lgkmcnt(0)" ::: "memory")
__device__ __forceinline__ unsigned f2bf(float f) { unsigned u = __builtin_bit_cast(unsigned, f); return (u + 0x7fffu + ((u >> 16) & 1u)) >> 16; }
__device__ __forceinline__ unsigned pk2(float lo, float hi) { return f2bf(lo) | (f2bf(hi) << 16); }
__device__ __forceinline__ float bflo(unsigned w) { return __builtin_bit_cast(float, w << 16); }
__device__ __forceinline__ float bfhi(unsigned w) { return __builtin_bit_cast(float, w & 0xffff0000u); }
__device__ __forceinline__ float bf2f(bf16 b) { return __builtin_bit_cast(float, ((unsigned)b) << 16); }
__device__ __forceinline__ float wave_sum(float v) {
#pragma unroll
    for (int o = 1; o < 64; o <<= 1) v += __shfl_xor(v, o);
    return v;
}
#define XB_TMO      128
#define XB_XCNT(j)  (256  + 64 * (j))
#define XB_XSUB(j)  (1280 + 64 * (j))
#define XB_XGEN(j)  (2304 + 64 * (j))
#define XB_TOP      3328
#define XB_TOPGEN   3392
#define XCD_BAR_WORDS 3456
#define XB_SPIN_CAP (1u << 18)

__device__ __forceinline__ unsigned xb_ld(unsigned* p)              { return __hip_atomic_load(p, __ATOMIC_RELAXED, __HIP_MEMORY_SCOPE_AGENT); }
__device__ __forceinline__ unsigned xb_add(unsigned* p, unsigned v) { return __hip_atomic_fetch_add(p, v, __ATOMIC_RELAXED, __HIP_MEMORY_SCOPE_AGENT); }
__device__ __forceinline__ unsigned xb_xcc_id() { return (unsigned)__builtin_amdgcn_s_getreg((3 << 11) | 20) & 0xFu; }
#define XB_SPIN(cond, bar) do { unsigned _sp = 0; while (cond) { __builtin_amdgcn_s_sleep(1); \
    if ((++_sp & 255u) == 0u) { if (xb_ld(&(bar)[XB_TMO])) break; if (_sp > XB_SPIN_CAP) { atomicAdd(&(bar)[XB_TMO], 1u); break; } } } } while (0)

struct XcdBarrier {
    unsigned* bar; unsigned x;
    volatile LAS unsigned* st;
};

__device__ __forceinline__ XcdBarrier xcd_barrier_post(unsigned* bar, volatile LAS unsigned* st) {
    XcdBarrier b; b.bar = bar; b.x = xb_xcc_id(); b.st = st;
    if (threadIdx.x == 0) (void)xb_add(&bar[XB_XCNT(b.x)], 1u);
    return b;
}
__device__ __forceinline__ void xcd_barrier_complete(unsigned* bar, unsigned x, unsigned& nloc, unsigned& nx) {
    const unsigned G = gridDim.x * gridDim.y * gridDim.z;
    unsigned sum, cnt, mine, sp = 0u;
    for (;;) {
        sum = 0u; cnt = 0u; mine = 0u;
#pragma unroll
        for (unsigned j = 0; j < 16; ++j) { const unsigned c = xb_ld(&bar[XB_XCNT(j)]); sum += c; cnt += (c > 0u) ? 1u : 0u; mine = (j == x) ? c : mine; }
        if (sum == G) break;
        __builtin_amdgcn_s_sleep(1);
        if ((++sp & 255u) == 0u) { if (xb_ld(&bar[XB_TMO])) break; if (sp > XB_SPIN_CAP) { atomicAdd(&bar[XB_TMO], 1u); break; } }
    }
    nloc = mine > 0u ? mine : 1u; nx = cnt > 0u ? cnt : 1u;
}

__device__ __forceinline__ void xcd_barrier(const XcdBarrier& b) {
    asm volatile("s_waitcnt vmcnt(0)" ::: "memory");
    __syncthreads();
    if (threadIdx.x == 0) {
        unsigned* bar = b.bar;
        __builtin_amdgcn_s_waitcnt(0);
        unsigned nloc = b.st[0], nx = b.st[1];
        if (nloc == 0u) { xcd_barrier_complete(bar, b.x, nloc, nx); b.st[0] = nloc; b.st[1] = nx; }
        const unsigned old = xb_add(&bar[XB_XSUB(b.x)], 1u);
        const unsigned gen = old / nloc;
        if (old + 1u == (gen + 1u) * nloc) {
            __builtin_amdgcn_fence(__ATOMIC_RELEASE, "agent");
            asm volatile("s_waitcnt vmcnt(0)" ::: "memory");
            const unsigned og = xb_add(&bar[XB_TOP], 1u);
            const unsigned tg = og / nx;
            if (og + 1u == (tg + 1u) * nx) xb_add(&bar[XB_TOPGEN], 1u);
            else XB_SPIN(xb_ld(&bar[XB_TOPGEN]) == tg, bar);
            __builtin_amdgcn_fence(__ATOMIC_ACQUIRE, "agent");
            xb_add(&bar[XB_XGEN(b.x)], 1u);
            asm volatile("s_waitcnt vmcnt(0)" ::: "memory");
        } else {
            XB_SPIN(xb_ld(&bar[XB_XGEN(b.x)]) == gen, bar);
            __builtin_amdgcn_fence(__ATOMIC_ACQUIRE, "agent");
            asm volatile("s_waitcnt vmcnt(0)" ::: "memory");
        }
    }
    __syncthreads();
}
__device__ __forceinline__ void tr_item(const float* W, int N, bf16* WT, int K, int k0, int n0, int drow0, LAS float* scr, int lane) {
#pragma unroll 8
    for (int i = 0; i < 32; ++i) { const int kk = 2 * i + (lane >> 5); scr[kk * 33 + (lane & 31)] = W[(size_t)(k0 + kk) * N + n0 + (lane & 31)]; }
    LDS_WAIT(); asm volatile("" ::: "memory");
    const int c = lane & 7;
#pragma unroll
    for (int j = 0; j < 4; ++j) { const int n = (lane >> 3) + 8 * j; const LAS float* s = scr + (8 * c) * 33 + n;
        v4u o; o.x = pk2(s[0 * 33], s[1 * 33]); o.y = pk2(s[2 * 33], s[3 * 33]); o.z = pk2(s[4 * 33], s[5 * 33]); o.w = pk2(s[6 * 33], s[7 * 33]);
        *(GAS v4u*)(WT + (size_t)(drow0 + n) * K + k0 + 8 * c) = o; }
    LDS_WAIT(); asm volatile("" ::: "memory");
}
struct LayerW { const float *g1, *u1, *d1, *win, *wout, *g2, *u2, *d2; };
__device__ __forceinline__ void convert_phase(const LayerW& w, unsigned char* wsw, LAS unsigned char* lds, int bid, int G, int wave, int lane, int tid) {
    LAS float* scr = (LAS float*)(lds + wave * 16384);
    const int gw = bid * NWAVES + wave, NGW = G * NWAVES;
    constexpr int I_GU = (D / 64) * (FF / 32), I_DN = (FF / 64) * (D / 32), I_IN = (D / 64) * (NIN / 32), I_OUT = (D / 64) * (D / 32);
    constexpr int NITEMS = 6 * I_GU + I_IN + I_OUT; static_assert(I_GU == I_DN, "items");
    bf16* WGU1 = (bf16*)(wsw + WO_GU1); bf16* WD1 = (bf16*)(wsw + WO_D1); bf16* WIN = (bf16*)(wsw + WO_IN); bf16* WOUT = (bf16*)(wsw + WO_OUT); bf16* WGU2 = (bf16*)(wsw + WO_GU2); bf16* WD2 = (bf16*)(wsw + WO_D2);
    for (int it = gw; it < NITEMS; it += NGW) {
        int r = it;
        if (r < 4 * I_GU) {
            const int which = r / I_GU; r -= which * I_GU; const int nblk = FF / 32, kb = r / nblk, nb = r % nblk, n0 = 32 * nb;
            const float* W = which == 0 ? w.g1 : which == 1 ? w.u1 : which == 2 ? w.g2 : w.u2;
            tr_item(W, FF, which < 2 ? WGU1 : WGU2, D, 64 * kb, n0, 256 * (n0 / 128) + 128 * (which & 1) + (n0 % 128), scr, lane); continue; }
        r -= 4 * I_GU;
        if (r < 2 * I_DN) { const int which = r / I_DN; r -= which * I_DN; const int nblk = D / 32, kb = r / nblk, nb = r % nblk;
            tr_item(which ? w.d2 : w.d1, D, which ? WD2 : WD1, FF, 64 * kb, 32 * nb, 32 * nb, scr, lane); continue; }
        r -= 2 * I_DN;
        if (r < I_IN) { const int nblk = NIN / 32, kb = r / nblk, nb = r % nblk, n0 = 32 * nb;
            const int drow = n0 < 1536 ? n0 : (n0 == 1536 ? PC_RF : n0 - 32);
            tr_item(w.win, NIN, WIN, D, 64 * kb, n0, drow, scr, lane); continue; }
        r -= I_IN;
        { const int nblk = D / 32, kb = r / nblk, nb = r % nblk; tr_item(w.wout, D, WOUT, D, 64 * kb, 32 * nb, 32 * nb, scr, lane); }
    }
    { GAS v4u* p = (GAS v4u*)(WIN + (size_t)NIN * D); const int n16 = (NINP - NIN) * D / 8; const v4u z = {0u, 0u, 0u, 0u};
      for (int i = bid * NTHR + tid; i < n16; i += G * NTHR) p[i] = z; }
}
__device__ __forceinline__ void cast_phase(const float* x, bf16* XB, int bid, int G, int tid) {
    const GAS f32x4* s = (const GAS f32x4*)x; GAS v2u* d = (GAS v2u*)XB;
    for (int i = bid * NTHR + tid; i < M * D / 4; i += G * NTHR) { const f32x4 v = s[i]; v2u o; o.x = pk2(v.x, v.y); o.y = pk2(v.z, v.w); d[i] = o; }
}
__device__ __forceinline__ void ln_phase(const float* Z, const float* g, const float* b, float* XF, bf16* XB, int bid, int G, int wave, int lane) {
    const int gw = bid * NWAVES + wave, NGW = G * NWAVES;
    for (int m = gw; m < M; m += NGW) {
        const GAS f32x4* zr = (const GAS f32x4*)(Z + (size_t)m * D) + lane;
        f32x4 v[8]; float s = 0.f;
#pragma unroll
        for (int j = 0; j < 8; ++j) { v[j] = zr[64 * j]; s += (v[j].x + v[j].y) + (v[j].z + v[j].w); }
        const float mean = wave_sum(s) * (1.f / D); float s2 = 0.f;
#pragma unroll
        for (int j = 0; j < 8; ++j) { v[j] = v[j] - mean; s2 += (v[j].x * v[j].x + v[j].y * v[j].y) + (v[j].z * v[j].z + v[j].w * v[j].w); }
        const float rstd = 1.f / sqrtf(wave_sum(s2) * (1.f / D) + LN_EPS);
        GAS f32x4* xo = (GAS f32x4*)(XF + (size_t)m * D) + lane; GAS v2u* bo = (GAS v2u*)(XB + (size_t)m * D) + lane;
#pragma unroll
        for (int j = 0; j < 8; ++j) { const f32x4 gg = ((const GAS f32x4*)g)[lane + 64 * j], bb = ((const GAS f32x4*)b)[lane + 64 * j];
            const f32x4 o = v[j] * rstd * gg + bb; xo[64 * j] = o; v2u w; w.x = pk2(o.x, o.y); w.y = pk2(o.z, o.w); bo[64 * j] = w; }
    }
}

constexpr int DIL_PITCH = 136;
__device__ __forceinline__ void dil_item(int item, const bf16* PROJ, float* OP, float* LSE, LAS unsigned char* lds, int tid) {
    const int tt = item & 63; int r3 = item >> 6; const int br = r3 % 3; r3 /= 3; const int h = r3 % DH, b = r3 / DH;
    const int d = br == 0 ? 1 : (br == 1 ? 4 : 16), tpr = 64 / d, res = tt / tpr, i0 = (tt % tpr) * 64, L = T / d;
    LAS bf16* Ks = (LAS bf16*)lds; LAS bf16* Vs = Ks + 192 * DIL_PITCH;
    const bf16* base = PROJ + (size_t)b * T * NINP;
    for (int c = tid; c < 192 * 16; c += NTHR) { const int row = c >> 4, ch = c & 15, i = i0 - 64 + row;
        v4u kv = {0u, 0u, 0u, 0u}, vv = {0u, 0u, 0u, 0u};
        if (i >= 0 && i < L) { const bf16* rp = base + (size_t)(res + d * i) * NINP + h * DE + ch * 8; kv = *(const GAS v4u*)(rp + PC_DK); vv = *(const GAS v4u*)(rp + PC_DV); }
        *(LAS v4u*)(Ks + row * DIL_PITCH + ch * 8) = kv; *(LAS v4u*)(Vs + row * DIL_PITCH + ch * 8) = vv; }
    const int qi = tid >> 3, e = tid & 7, tq = res + d * (i0 + qi);
    float q[16];
    { const bf16* qp = base + (size_t)tq * NINP + PC_DQ + h * DE + e * 16; const v4u a = *(const GAS v4u*)qp, c = *(const GAS v4u*)(qp + 8);
      q[0] = bflo(a.x); q[1] = bfhi(a.x); q[2] = bflo(a.y); q[3] = bfhi(a.y); q[4] = bflo(a.z); q[5] = bfhi(a.z); q[6] = bflo(a.w); q[7] = bfhi(a.w);
      q[8] = bflo(c.x); q[9] = bfhi(c.x); q[10] = bflo(c.y); q[11] = bfhi(c.y); q[12] = bflo(c.z); q[13] = bfhi(c.z); q[14] = bflo(c.w); q[15] = bfhi(c.w); }
    __syncthreads();
    const float slope = exp2f(-8.0f * (float)(h + 1) / (float)DH) * (float)d, scale = 0.08838834764831845f;
    float mx = -1e30f, l = 0.f, acc[16];
#pragma unroll
    for (int x = 0; x < 16; ++x) acc[x] = 0.f;
    for (int jj = 0; jj <= 128; ++jj) {
        const int kr = qi + jj, i = i0 - 64 + kr;
        const LAS bf16* kp = Ks + kr * DIL_PITCH + e * 16; const v4u a = *(const LAS v4u*)kp, c = *(const LAS v4u*)(kp + 8);
        float dot = q[0] * bflo(a.x) + q[1] * bfhi(a.x) + q[2] * bflo(a.y) + q[3] * bfhi(a.y) + q[4] * bflo(a.z) + q[5] * bfhi(a.z) + q[6] * bflo(a.w) + q[7] * bfhi(a.w)
                  + q[8] * bflo(c.x) + q[9] * bfhi(c.x) + q[10] * bflo(c.y) + q[11] * bfhi(c.y) + q[12] * bflo(c.z) + q[13] * bfhi(c.z) + q[14] * bflo(c.w) + q[15] * bfhi(c.w);
        dot += __shfl_xor(dot, 1); dot += __shfl_xor(dot, 2); dot += __shfl_xor(dot, 4);
        if (i >= 0 && i < L) {
            const int aj = jj < 64 ? 64 - jj : jj - 64;
            const float s = dot * scale - slope * (float)aj, mn = fmaxf(mx, s), corr = __expf(mx - mn), p = __expf(s - mn);
            const LAS bf16* vp = Vs + kr * DIL_PITCH + e * 16; const v4u va = *(const LAS v4u*)vp, vc = *(const LAS v4u*)(vp + 8);
            l = l * corr + p; mx = mn;
            acc[0] = acc[0] * corr + p * bflo(va.x); acc[1] = acc[1] * corr + p * bfhi(va.x); acc[2] = acc[2] * corr + p * bflo(va.y); acc[3] = acc[3] * corr + p * bfhi(va.y);
            acc[4] = acc[4] * corr + p * bflo(va.z); acc[5] = acc[5] * corr + p * bfhi(va.z); acc[6] = acc[6] * corr + p * bflo(va.w); acc[7] = acc[7] * corr + p * bfhi(va.w);
            acc[8] = acc[8] * corr + p * bflo(vc.x); acc[9] = acc[9] * corr + p * bfhi(vc.x); acc[10] = acc[10] * corr + p * bflo(vc.y); acc[11] = acc[11] * corr + p * bfhi(vc.y);
            acc[12] = acc[12] * corr + p * bflo(vc.z); acc[13] = acc[13] * corr + p * bfhi(vc.z); acc[14] = acc[14] * corr + p * bflo(vc.w); acc[15] = acc[15] * corr + p * bfhi(vc.w);
        }
    }
    const float inv = 1.f / l; const size_t tok = (size_t)b * T + tq;
    GAS f32x4* op = (GAS f32x4*)(OP + ((size_t)br * M + tok) * DD + h * DE + e * 16);
#pragma unroll
    for (int x = 0; x < 4; ++x) op[x] = (f32x4){acc[4 * x] * inv, acc[4 * x + 1] * inv, acc[4 * x + 2] * inv, acc[4 * x + 3] * inv};
    if (e == 0) LSE[((size_t)br * M + tok) * DH + h] = mx + __logf(l);
    __syncthreads();
}
__device__ __forceinline__ void dil_merge_item(int item, const float* OP, const float* LSE, bf16* CAT, int tid) {
    for (int e = tid; e < 32 * (DD / 4); e += NTHR) { const int tk = e / (DD / 4), c4 = e % (DD / 4), col = 4 * c4, h = col / DE; const size_t tok = (size_t)item * 32 + tk;
        const float l0 = LSE[((size_t)0 * M + tok) * DH + h], l1 = LSE[((size_t)1 * M + tok) * DH + h], l2 = LSE[((size_t)2 * M + tok) * DH + h];
        const float mm = fmaxf(l0, fmaxf(l1, l2)), w0 = __expf(l0 - mm), w1 = __expf(l1 - mm), w2 = __expf(l2 - mm), inv = 1.f / (w0 + w1 + w2);
        const f32x4 a = *(const GAS f32x4*)(OP + ((size_t)0 * M + tok) * DD + col), bq = *(const GAS f32x4*)(OP + ((size_t)1 * M + tok) * DD + col), c = *(const GAS f32x4*)(OP + ((size_t)2 * M + tok) * DD + col);
        const f32x4 o = (a * w0 + bq * w1 + c * w2) * inv; v2u w; w.x = pk2(o.x, o.y); w.y = pk2(o.z, o.w);
        *(GAS v2u*)(CAT + tok * D + GDV + col) = w; }
}
__device__ __forceinline__ void conv_item(int item, const bf16* PROJ, const float* cw, const float* cb, const float* lg, const float* lb, bf16* CAT, LAS unsigned char* lds, int tid, int wave, int lane) {
    const int b = item / (T / 32), t0 = (item % (T / 32)) * 32;
    LAS float* us = (LAS float*)lds;
    for (int c = tid; c < 62 * 64; c += NTHR) { const int rr = c >> 6, ch = c & 63, t = t0 - 15 + rr; float u[8];
        if (t >= 0 && t < T) { const bf16* rp = PROJ + ((size_t)b * T + t) * NINP + ch * 8; const v4u a = *(const GAS v4u*)(rp + PC_CVAL), g = *(const GAS v4u*)(rp + PC_CGATE);
            const float av[8] = {bflo(a.x), bfhi(a.x), bflo(a.y), bfhi(a.y), bflo(a.z), bfhi(a.z), bflo(a.w), bfhi(a.w)}, gv[8] = {bflo(g.x), bfhi(g.x), bflo(g.y), bfhi(g.y), bflo(g.z), bfhi(g.z), bflo(g.w), bfhi(g.w)};
#pragma unroll
            for (int x = 0; x < 8; ++x) u[x] = av[x] / (1.f + __expf(-gv[x]));
        } else {
#pragma unroll
            for (int x = 0; x < 8; ++x) u[x] = 0.f; }
        *(LAS f32x4*)(us + rr * CC + ch * 8) = (f32x4){u[0], u[1], u[2], u[3]}; *(LAS f32x4*)(us + rr * CC + ch * 8 + 4) = (f32x4){u[4], u[5], u[6], u[7]}; }
    __syncthreads();
    float y[32];
    { const int c = tid; const float bias = cb[c];
#pragma unroll
      for (int tk = 0; tk < 32; ++tk) y[tk] = bias;
      for (int j = 0; j < CK; ++j) { const float wj = cw[j * CC + c];
#pragma unroll
          for (int tk = 0; tk < 32; ++tk) y[tk] += us[(tk + j) * CC + c] * wj; } }
    __syncthreads();
#pragma unroll
    for (int tk = 0; tk < 32; ++tk) us[tk * CC + tid] = y[tk];
    __syncthreads();
    for (int q = 0; q < 4; ++q) { const int tk = wave * 4 + q; const LAS float* yr = us + tk * CC + lane * 8; float v[8]; float s = 0.f;
#pragma unroll
        for (int x = 0; x < 8; ++x) { v[x] = yr[x]; s += v[x]; }
        const float mean = wave_sum(s) * (1.f / CC); float s2 = 0.f;
#pragma unroll
        for (int x = 0; x < 8; ++x) { v[x] -= mean; s2 += v[x] * v[x]; }
        const float rstd = 1.f / sqrtf(wave_sum(s2) * (1.f / CC) + LN_EPS); float o[8];
#pragma unroll
        for (int x = 0; x < 8; ++x) { const float z = v[x] * rstd * lg[lane * 8 + x] + lb[lane * 8 + x]; o[x] = z / (1.f + __expf(-z)); }
        v4u w; w.x = pk2(o[0], o[1]); w.y = pk2(o[2], o[3]); w.z = pk2(o[4], o[5]); w.w = pk2(o[6], o[7]);
        *(GAS v4u*)(CAT + ((size_t)b * T + t0 + tk) * D + GDV + DD + lane * 8) = w; }
    __syncthreads();
}
__device__ __forceinline__ void gla1_item(int item, const bf16* PROJ, const float* wf, const float* bf_, const float* wb, const float* bb_, float* U, float* LAF, float* LAB, float* DEC, LAS unsigned char* lds, int tid) {
    const int h = item & 3, n = (item >> 2) & 63, b = item >> 8; const size_t tok0 = (size_t)b * T + (size_t)n * GC;
    LAS float* kk = (LAS float*)lds; LAS float* vv = kk + 64 * 96; LAS float* cf = vv + 64 * 192; LAS float* cb = cf + 64 * 96; LAS float* rf = cb + 64 * 96; LAS float* rb = rf + 64 * 16;
    for (int c = tid; c < 64 * 12; c += NTHR) { const int row = c / 12, ch = c % 12; const v4u a = *(const GAS v4u*)(PROJ + (tok0 + row) * NINP + PC_GK + h * GK + ch * 8); LAS float* o = kk + row * 96 + ch * 8;
        o[0] = bflo(a.x); o[1] = bfhi(a.x); o[2] = bflo(a.y); o[3] = bfhi(a.y); o[4] = bflo(a.z); o[5] = bfhi(a.z); o[6] = bflo(a.w); o[7] = bfhi(a.w); }
    for (int c = tid; c < 64 * 24; c += NTHR) { const int row = c / 24, ch = c % 24; const v4u a = *(const GAS v4u*)(PROJ + (tok0 + row) * NINP + PC_GV + h * GV + ch * 8); LAS float* o = vv + row * 192 + ch * 8;
        o[0] = bflo(a.x); o[1] = bfhi(a.x); o[2] = bflo(a.y); o[3] = bfhi(a.y); o[4] = bflo(a.z); o[5] = bfhi(a.z); o[6] = bflo(a.w); o[7] = bfhi(a.w); }
    for (int c = tid; c < 64 * 32; c += NTHR) { const int row = c >> 5, x = c & 31; const float v = bf2f(PROJ[(tok0 + row) * NINP + PC_RF + x]); if (x < 16) rf[row * 16 + x] = v; else rb[row * 16 + x - 16] = v; }
    __syncthreads();
    for (int idx = tid; idx < 64 * 96; idx += NTHR) { const int c = idx / 96, k = idx % 96, hk = h * GK + k; float zf = bf_[hk], zb = bb_[hk];
#pragma unroll
        for (int r = 0; r < 16; ++r) { zf += rf[c * 16 + r] * wf[r * GDK + hk]; zb += rb[c * 16 + r] * wb[r * GDK + hk]; }
        cf[idx] = (fminf(zf, 0.f) - log1pf(expf(-fabsf(zf)))) * (1.f / 16.f); cb[idx] = (fminf(zb, 0.f) - log1pf(expf(-fabsf(zb)))) * (1.f / 16.f); }
    __syncthreads();
    if (tid < 96) { float run = 0.f;
#pragma unroll 4
        for (int c = 0; c < 64; ++c) { run += cf[c * 96 + tid]; cf[c * 96 + tid] = run; } }
    else if (tid < 192) { const int k = tid - 96; float run = 0.f;
#pragma unroll 4
        for (int c = 63; c >= 0; --c) { run += cb[c * 96 + k]; cb[c * 96 + k] = run; } }
    __syncthreads();
    for (int idx = tid; idx < 64 * 96; idx += NTHR) { const int c = idx / 96, k = idx % 96; LAF[(tok0 + c) * GDK + h * GK + k] = cf[idx]; LAB[(tok0 + c) * GDK + h * GK + k] = cb[idx]; }
    const size_t cid = ((size_t)(b * NCH + n) * GH + h) * 2;
    if (tid < 96) DEC[(cid + 0) * GK + tid] = __expf(cf[63 * 96 + tid]); else if (tid < 192) DEC[(cid + 1) * GK + tid - 96] = __expf(cb[tid - 96]);
    __syncthreads();
    if (tid < 96) { const float e = cf[63 * 96 + tid];
#pragma unroll 4
        for (int s = 0; s < 64; ++s) cf[s * 96 + tid] = kk[s * 96 + tid] * __expf(e - cf[s * 96 + tid]); }
    else if (tid < 192) { const int k = tid - 96; const float e = cb[k];
#pragma unroll 4
        for (int s = 63; s >= 0; --s) cb[s * 96 + k] = kk[s * 96 + k] * __expf(e - cb[s * 96 + k]); }
    __syncthreads();
#pragma unroll 1
    for (int j = 0; j < 36; ++j) { const int o = tid + NTHR * j, k = o / 192, v = o % 192; float af = 0.f, ab = 0.f;
#pragma unroll 8
        for (int s = 0; s < 64; ++s) { const float x = vv[s * 192 + v]; af += cf[s * 96 + k] * x; ab += cb[s * 96 + k] * x; }
        U[(cid + 0) * (GK * GV) + o] = af; U[(cid + 1) * (GK * GV) + o] = ab; }
    __syncthreads();
}
__device__ __forceinline__ void gla2_phase(float* U, const float* DEC, int bid, int G, int tid) {
    for (int e = bid * NTHR + tid; e < BATCH * GH * 2 * GK * GV; e += G * NTHR) {
        const int kv = e % (GK * GV); int r = e / (GK * GV); const int dir = r & 1; r >>= 1; const int h = r % GH, b = r / GH, k = kv / GV; float S = 0.f;
        for (int st = 0; st < NCH; ++st) { const int n = dir ? NCH - 1 - st : st; const size_t cid = ((size_t)(b * NCH + n) * GH + h) * 2 + dir;
            const float u = U[cid * (GK * GV) + kv], dc = DEC[cid * GK + k]; U[cid * (GK * GV) + kv] = S; S = dc * S + u; }
    }
}
__device__ __forceinline__ void gla3_item(int item, const bf16* PROJ, const float* U, const float* LAF, const float* LAB, const float* gn, bf16* CAT, LAS unsigned char* lds, int tid, int wave, int lane) {
    const int h = item & 3, n = (item >> 2) & 63, b = item >> 8; const size_t tok0 = (size_t)b * T + (size_t)n * GC;
    LAS float* qdT = (LAS float*)lds; LAS float* kiT = qdT + 96 * 64; LAS float* vv = kiT + 96 * 64; LAS float* attT = vv + 64 * 192; LAS float* obuf = qdT;
    for (int c = tid; c < 64 * 24; c += NTHR) { const int row = c / 24, ch = c % 24; const v4u a = *(const GAS v4u*)(PROJ + (tok0 + row) * NINP + PC_GV + h * GV + ch * 8); LAS float* o = vv + row * 192 + ch * 8;
        o[0] = bflo(a.x); o[1] = bfhi(a.x); o[2] = bflo(a.y); o[3] = bfhi(a.y); o[4] = bflo(a.z); o[5] = bfhi(a.z); o[6] = bflo(a.w); o[7] = bfhi(a.w); }
    const int v = tid % 192, cg = tid / 192;
    float acc[32];
#pragma unroll
    for (int i = 0; i < 32; ++i) acc[i] = 0.f;
    const size_t cid = ((size_t)(b * NCH + n) * GH + h) * 2;
    for (int dir = 0; dir < 2; ++dir) {
        const float* LA = dir ? LAB : LAF;
        for (int idx = tid; idx < 64 * 96; idx += NTHR) { const int c = idx / 96, k = idx % 96; const float bc = LA[(tok0 + c) * GDK + h * GK + k];
            const float qv = bf2f(PROJ[(tok0 + c) * NINP + PC_GQ + h * GK + k]), kv = bf2f(PROJ[(tok0 + c) * NINP + PC_GK + h * GK + k]);
            qdT[k * 64 + c] = qv * 0.10206207261596577f * __expf(bc); kiT[k * 64 + c] = kv * __expf(-bc); }
        __syncthreads();
        for (int j = 0; j < 8; ++j) { const int idx = tid + NTHR * j, s = idx >> 6, c = idx & 63; float a = 0.f;
            if (dir ? (s >= c) : (s <= c)) { for (int k = 0; k < 96; ++k) a += qdT[k * 64 + c] * kiT[k * 64 + s]; }
            attT[s * 64 + c] = a; }
        __syncthreads();
        if (tid < 384) {
            for (int s = 0; s < 64; ++s) { const float x = vv[s * 192 + v]; const LAS f32x4* ap = (const LAS f32x4*)(attT + s * 64 + 32 * cg);
#pragma unroll
                for (int i = 0; i < 8; ++i) { const f32x4 a = ap[i]; acc[4 * i] += a.x * x; acc[4 * i + 1] += a.y * x; acc[4 * i + 2] += a.z * x; acc[4 * i + 3] += a.w * x; } }
            const float* Sp = U + (cid + dir) * (GK * GV) + v;
            for (int k = 0; k < 96; ++k) { const float x = Sp[k * GV]; const LAS f32x4* qp = (const LAS f32x4*)(qdT + k * 64 + 32 * cg);
#pragma unroll
                for (int i = 0; i < 8; ++i) { const f32x4 a = qp[i]; acc[4 * i] += a.x * x; acc[4 * i + 1] += a.y * x; acc[4 * i + 2] += a.z * x; acc[4 * i + 3] += a.w * x; } }
        }
        __syncthreads();
    }
    if (tid < 384) {
#pragma unroll
        for (int i = 0; i < 32; ++i) obuf[(32 * cg + i) * 192 + v] = acc[i]; }
    __syncthreads();
    for (int cc = 0; cc < 8; ++cc) { const int c = wave * 8 + cc; float x[3], ss = 0.f;
#pragma unroll
        for (int j = 0; j < 3; ++j) { x[j] = obuf[c * 192 + lane + 64 * j]; ss += x[j] * x[j]; }
        const float r = 1.f / sqrtf(wave_sum(ss) * (1.f / GV) + LN_EPS);
#pragma unroll
        for (int j = 0; j < 3; ++j) { const int vc = lane + 64 * j; const float g = bf2f(PROJ[(tok0 + c) * NINP + PC_GG + h * GV + vc]);
            const float o = x[j] * r * gn[h * GV + vc] * (g / (1.f + __expf(-g))); CAT[(tok0 + c) * D + h * GV + vc] = (bf16)f2bf(o); } }
    __syncthreads();
}
typedef __attribute__((address_space(4))) const unsigned long long kargq;
__device__ __forceinline__ kargq* karg_base() { kargq* kp = (kargq*)__builtin_amdgcn_kernarg_segment_ptr(); asm volatile("" : "+s"(kp)); return kp; }
__device__ __forceinline__ const float* karg_in(int i) { return (const float*)karg_base()[i]; }
__device__ __forceinline__ float* karg_out() { return (float*)karg_base()[24]; }
__device__ __forceinline__ unsigned char* karg_ws() { return (unsigned char*)karg_base()[25]; }
struct Args { const float* in[24]; float* out; unsigned char* ws; };
#ifndef STOP_AFTER
#define STOP_AFTER 1000000
#endif
__global__ void __launch_bounds__(NTHR, 2) fwd_kernel(Args a) {
    extern __shared__ __attribute__((aligned(16))) unsigned char lds_raw[];
    LAS unsigned char* lds = (LAS unsigned char*)lds_raw;
    volatile LAS unsigned* MISC = (volatile LAS unsigned*)(lds + MISC_OFF);
    const int tid0 = threadIdx.x;
#define IDS() int tid = threadIdx.x; asm volatile("" : "+v"(tid)); const int lane = tid & 63, wave = __builtin_amdgcn_readfirstlane(tid >> 6); int G = gridDim.x, bid = blockIdx.x; asm volatile("" : "+s"(G), "+s"(bid)); (void)lane; (void)wave
    if (tid0 < 32) MISC[tid0] = 0u;
    __syncthreads();
    XcdBarrier bar = xcd_barrier_post((unsigned*)(karg_ws() + WS_CTL) + CW_BAR, MISC + 8);
    int phase_no = 0;
#define GRID_BAR() do { XcdBarrier b2_ = bar; asm volatile("" : "+s"(b2_.bar)); xcd_barrier(b2_); if (++phase_no > STOP_AFTER) return; } while (0)

#define XF ((float*)(karg_ws() + WS_XF))
#define Z ((float*)(karg_ws() + WS_Z))
#define XB ((bf16*)(karg_ws() + WS_XB))
#define CAT ((bf16*)(karg_ws() + WS_CAT))
#define HB ((bf16*)(karg_ws() + WS_HP))
#define PROJ ((bf16*)(karg_ws() + WS_HP))
#define U ((float*)(karg_ws() + WS_U))
#define LAF ((float*)(karg_ws() + WS_LAF))
#define LAB ((float*)(karg_ws() + WS_LAB))
#define DEC ((float*)(karg_ws() + WS_DEC))
#define OP ((float*)(karg_ws() + WS_OP))
#define LSE ((float*)(karg_ws() + WS_LSE))
#define wsw (karg_ws() + WS_W)
#define WGU1 ((bf16*)(wsw + WO_GU1))
#define WD1 ((bf16*)(wsw + WO_D1))
#define WIN ((bf16*)(wsw + WO_IN))
#define WOUT ((bf16*)(wsw + WO_OUT))
#define WGU2 ((bf16*)(wsw + WO_GU2))
#define WD2 ((bf16*)(wsw + WO_D2))
    for (int l = 0; l < DEPTH; ++l) {
        { IDS(); LayerW w; const size_t so = (size_t)l * D * FF;
          w.g1 = karg_in(1) + so; w.u1 = karg_in(2) + so; w.d1 = karg_in(3) + so; w.win = karg_in(6) + (size_t)l * D * NIN; w.wout = karg_in(16) + (size_t)l * D * D;
          w.g2 = karg_in(19) + so; w.u2 = karg_in(20) + so; w.d2 = karg_in(21) + so;
          convert_phase(w, wsw, lds, bid, G, wave, lane, tid);
          if (l == 0) cast_phase(karg_in(0), XB, bid, G, tid); }
        GRID_BAR();
        { IDS(); pg8::Gemm g{XB, WGU1, M, NGU, D}; pg8::StaticOrder S; S.init(M, NGU, G, bid); pg8::EpiSwiglu E{HB, FF};
          pg8::gemm_phase<pg8::EpiSwiglu, pg8::StaticOrder, true, true>(lds, g, S, E); }
        GRID_BAR();
        { IDS(); pg8::Gemm g{HB, WD1, M, D, FF}; pg8::StaticOrder S; S.init(M, D, G, bid); pg8::EpiResid E{l == 0 ? karg_in(0) : XF, Z, D, DN_ALPHA, 0.5f};
          pg8::gemm_phase<pg8::EpiResid, pg8::StaticOrder, true, true>(lds, g, S, E); }
        GRID_BAR();
        { IDS(); ln_phase(Z, karg_in(4) + (size_t)l * D, karg_in(5) + (size_t)l * D, XF, XB, bid, G, wave, lane); }
        GRID_BAR();
        { IDS(); pg8::Gemm g{XB, WIN, M, NINP, D}; pg8::StaticOrder S; S.init(M, NINP, G, bid); pg8::EpiBf16 E{PROJ, NINP};
          pg8::gemm_phase<pg8::EpiBf16, pg8::StaticOrder, true, true>(lds, g, S, E); }
        GRID_BAR();
        { IDS(); constexpr int N_DIL = BATCH * DH * 3 * 64, N_G1 = BATCH * NCH * GH, N_CV = BATCH * (T / 32);
          for (int it = bid; it < N_DIL + N_G1 + N_CV; it += G) {
              if (it < N_DIL) dil_item(it, PROJ, OP, LSE, lds, tid);
              else if (it < N_DIL + N_G1) gla1_item(it - N_DIL, PROJ, karg_in(7) + (size_t)l * GR * GDK, karg_in(8) + (size_t)l * GDK, karg_in(9) + (size_t)l * GR * GDK, karg_in(10) + (size_t)l * GDK, U, LAF, LAB, DEC, lds, tid);
              else conv_item(it - N_DIL - N_G1, PROJ, karg_in(12) + (size_t)l * CK * CC, karg_in(13) + (size_t)l * CC, karg_in(14) + (size_t)l * CC, karg_in(15) + (size_t)l * CC, CAT, lds, tid, wave, lane);
          } }
        GRID_BAR();
        { IDS(); gla2_phase(U, DEC, bid, G, tid); }
        GRID_BAR();
        { IDS(); constexpr int N_G3 = BATCH * NCH * GH, N_MG = M / 32;
          for (int it = bid; it < N_G3 + N_MG; it += G) {
              if (it < N_G3) gla3_item(it, PROJ, U, LAF, LAB, karg_in(11) + (size_t)l * GDV, CAT, lds, tid, wave, lane);
              else dil_merge_item(it - N_G3, OP, LSE, CAT, tid);
          } }
        GRID_BAR();
        { IDS(); pg8::Gemm g{CAT, WOUT, M, D, D}; pg8::StaticOrder S; S.init(M, D, G, bid); pg8::EpiResid E{XF, Z, D, DN_ALPHA, 1.0f};
          pg8::gemm_phase<pg8::EpiResid, pg8::StaticOrder, true, true>(lds, g, S, E); }
        GRID_BAR();
        { IDS(); ln_phase(Z, karg_in(17) + (size_t)l * D, karg_in(18) + (size_t)l * D, XF, XB, bid, G, wave, lane); }
        GRID_BAR();
        { IDS(); pg8::Gemm g{XB, WGU2, M, NGU, D}; pg8::StaticOrder S; S.init(M, NGU, G, bid); pg8::EpiSwiglu E{HB, FF};
          pg8::gemm_phase<pg8::EpiSwiglu, pg8::StaticOrder, true, true>(lds, g, S, E); }
        GRID_BAR();
        { IDS(); pg8::Gemm g{HB, WD2, M, D, FF}; pg8::StaticOrder S; S.init(M, D, G, bid); pg8::EpiResid E{XF, Z, D, DN_ALPHA, 0.5f};
          pg8::gemm_phase<pg8::EpiResid, pg8::StaticOrder, true, true>(lds, g, S, E); }
        GRID_BAR();
        { IDS(); ln_phase(Z, karg_in(22) + (size_t)l * D, karg_in(23) + (size_t)l * D, l == DEPTH - 1 ? karg_out() : XF, XB, bid, G, wave, lane); }
        GRID_BAR();
    }
}

extern "C" void kernel_launch(void* const* d_in, const int* in_sizes, int n_in, void* d_out, int out_size, void* d_ws, size_t ws_size, hipStream_t stream) {
    static int grid = 0;
    if (grid == 0) {
        if (n_in != 24 || in_sizes[0] != M * D || out_size != M * D || ws_size < WS_END) { fprintf(stderr, "kernel_launch: unexpected problem shape / workspace (n_in %d, ws %zu < %zu); nothing launched\n", n_in, ws_size, (size_t)WS_END); grid = -1; return; }
        int dev = 0, cus = 0, per_cu = 0;
        if (hipGetDevice(&dev) != hipSuccess || hipDeviceGetAttribute(&cus, hipDeviceAttributeMultiprocessorCount, dev) != hipSuccess) { grid = -1; return; }
        if (hipFuncSetAttribute((const void*)fwd_kernel, hipFuncAttributeMaxDynamicSharedMemorySize, LDS_BYTES) != hipSuccess) { fprintf(stderr, "kernel_launch: hipFuncSetAttribute failed\n"); grid = -1; return; }
        if (hipOccupancyMaxActiveBlocksPerMultiprocessor(&per_cu, (const void*)fwd_kernel, NTHR, LDS_BYTES) != hipSuccess || per_cu < 1) fprintf(stderr, "kernel_launch: occupancy query reports %d\n", per_cu);
        (void)hipGetLastError();
        grid = cus;
    }
    if (grid < 0) return;
    if (hipMemsetAsync((char*)d_ws + WS_CTL, 0, CTL_ZERO_BYTES, stream) != hipSuccess) return;
    Args a{};
    for (int i = 0; i < 24; ++i) a.in[i] = (const float*)d_in[i];
    a.out = (float*)d_out; a.ws = (unsigned char*)d_ws;
    hipLaunchKernelGGL(fwd_kernel, dim3(grid), dim3(NTHR), LDS_BYTES, stream, a);
}
```

```cpp
#include <hip/hip_runtime.h>
#include <cstdio>
#include <cstdint>
namespace pg8 {
#define PG8_LAS __attribute__((address_space(3)))
typedef unsigned short bf16_t;
typedef short bf16x8 __attribute__((ext_vector_type(8)));
typedef float f32x4 __attribute__((ext_vector_type(4)));
typedef unsigned u32x4 __attribute__((ext_vector_type(4)));
constexpr int BM = 256, BK = 64, HALF = 128, HTB = HALF * BK * 2  , STAGE_BYTES = 8 * HTB, NXCD = 8, WGM = 8;

__host__ __device__ __forceinline__ int lds_byte(int r, int c) { const int st = (r >> 4) * 2 + (c >> 5), rr = r & 15, cc = c & 31, ob = rr * 64 + cc * 2; return st * 1024 + (ob ^ (((ob >> 9) & 1) << 5)); }
__host__ __device__ __forceinline__ void stage_rc(int b, int& R, int& C) { const int st = b / 1024, sb = b % 1024, swz = sb ^ (((sb >> 9) & 1) << 5); R = (st >> 1) * 16 + swz / 64; C = (st & 1) * 32 + (swz % 64) / 2; }
__host__ __device__ __forceinline__ int perm32(int rho) { const int n = rho >> 4, i = rho & 15; return 8 * (i >> 2) + 4 * n + (i & 3); }

struct Unit { int pm, pn; };
struct Gemm { const bf16_t* A; const bf16_t* Bt; int M, N, K; };

struct StaticOrder {
    int nM, nN, nwg, G, c;
    __host__ __device__ void init(int M, int N, int G_, int c_) { nM = M / BM; nN = N / BM; nwg = nM * nN; G = G_; c = c_; }
    __host__ __device__ bool next(int i, Unit& u) const {
        const long L = (long)i * G + c; if (L >= nwg) return false;
        int wgid = (int)L; { const int q = nwg / NXCD, r = nwg % NXCD, xcd = wgid % NXCD, off = wgid / NXCD; wgid = (xcd < r ? xcd * (q + 1) : r * (q + 1) + (xcd - r) * q) + off; }
        const int nig = WGM * nN, gid = wgid / nig, fm = gid * WGM, gsz = (nM - fm) < WGM ? (nM - fm) : WGM;
        u.pm = fm + ((wgid % nig) % gsz); u.pn = (wgid % nig) / gsz; return true;
    }
    __device__ __forceinline__ void a_ready(const Unit&) const {}
    __device__ __forceinline__ void done(const Unit&) const {}
};

template <class Epi, class Sched, bool ALIGN_EPI = false, bool SP2 = false>
__device__ __forceinline__ void gemm_phase(PG8_LAS unsigned char* lds, const Gemm g, const Sched& S, const Epi& E) {
    int tid_l = threadIdx.x; asm volatile("" : "+v"(tid_l));
    const int tid = tid_l, wid = __builtin_amdgcn_readfirstlane(tid >> 6), lane = tid & 63, wr = wid >> 2, wc = wid & 3, fr = lane & 15, fq = lane >> 4;
    const int K = g.K, nt = K / BK;
    unsigned voffA[2], voffB[2];
#pragma unroll
    for (int i = 0; i < 2; ++i) { int R, C; stage_rc(tid * 16 + i * 8192, R, C); const int Rb = Epi::PERM ? ((R & ~31) + perm32(R & 31)) : R;
        voffA[i] = (unsigned)(R * K + C) * 2u; voffB[i] = (unsigned)(Rb * K + C) * 2u; }
    const size_t kstep = (size_t)(BK * 2);
    const size_t hstep = (size_t)HALF * K * 2;
    const size_t tstep = 2 * hstep;
    const unsigned ldsw = (unsigned)wid * 1024u;
    const int aoff = lds_byte(wr * 64 + fr, fq * 8), boff = lds_byte(wc * 32 + fr, fq * 8);
#define PG8_SA(b, h) (((b) * 2 + (h)) * HTB)
#define PG8_SB(b, h) ((4 + (b) * 2 + (h)) * HTB)
#define PG8_STAGE(bufoff, gbase, voff) do { _Pragma("unroll") for (int _i = 0; _i < 2; ++_i) \
        __builtin_amdgcn_global_load_lds((const unsigned*)((const char*)(gbase) + (voff)[_i]), (PG8_LAS unsigned*)(lds + (bufoff) + ldsw + _i * 8192), 16, 0, 0); } while (0)
#define PG8_LDA(dst, b, h) do { _Pragma("unroll") for (int m = 0; m < 4; ++m) _Pragma("unroll") for (int k = 0; k < 2; ++k) dst[m][k] = *(const PG8_LAS bf16x8*)(lds + PG8_SA(b, h) + aoff + m * 2048 + k * 1024); } while (0)
#define PG8_LDB(dst, b, h) do { _Pragma("unroll") for (int n = 0; n < 2; ++n) _Pragma("unroll") for (int k = 0; k < 2; ++k) dst[n][k] = *(const PG8_LAS bf16x8*)(lds + PG8_SB(b, h) + boff + n * 2048 + k * 1024); } while (0)
#define PG8_MMA(ai, bj, At, Bt) do { __builtin_amdgcn_s_setprio(1); _Pragma("unroll") for (int m = 0; m < 4; ++m) _Pragma("unroll") for (int n = 0; n < 2; ++n) _Pragma("unroll") for (int k = 0; k < 2; ++k) \
        acc[ai][bj][m][n] = __builtin_amdgcn_mfma_f32_16x16x32_bf16(Bt[n][k], At[m][k], acc[ai][bj][m][n], 0, 0, 0); __builtin_amdgcn_s_setprio(0); } while (0)
#define PG8_WAIT_V(n) asm volatile("s_waitcnt vmcnt(" #n ")" ::: "memory")
#define PG8_WAIT_L(n) asm volatile("s_waitcnt lgkmcnt(" #n ")" ::: "memory")
#define PG8_BAR __builtin_amdgcn_s_barrier()
#define PG8_SCHED __builtin_amdgcn_sched_barrier(0)
    Unit cur, nxt; int ui = 0;
    if (!S.next(0, cur)) return;
    f32x4 acc[2][2][4][2];
#pragma unroll
    for (int a = 0; a < 2; ++a)
#pragma unroll
        for (int b = 0; b < 2; ++b)
#pragma unroll
            for (int m = 0; m < 4; ++m)
#pragma unroll
                for (int n = 0; n < 2; ++n) acc[a][b][m][n] = (f32x4){0.f, 0.f, 0.f, 0.f};
    bf16x8 At[4][2], B0[2][2], B1[2][2];
    const char* cA = (const char*)g.A + (size_t)cur.pm * tstep; const char* cB = (const char*)g.Bt + (size_t)cur.pn * tstep;
    S.a_ready(cur);
    if constexpr (SP2) {
        PG8_STAGE(PG8_SB(0, 0), cB, voffB); PG8_STAGE(PG8_SB(0, 1), cB + hstep, voffB); PG8_STAGE(PG8_SA(0, 0), cA, voffA); PG8_STAGE(PG8_SA(0, 1), cA + hstep, voffA);
        if (wr == 1) PG8_BAR;
        PG8_WAIT_V(2); PG8_BAR;
        PG8_STAGE(PG8_SB(1, 0), cB + kstep, voffB); PG8_STAGE(PG8_SA(1, 0), cA + kstep, voffA); PG8_STAGE(PG8_SB(1, 1), cB + hstep + kstep, voffB);
        PG8_WAIT_V(6); PG8_BAR;
    } else {
        PG8_STAGE(PG8_SB(0, 0), cB, voffB); PG8_STAGE(PG8_SA(0, 0), cA, voffA); PG8_STAGE(PG8_SB(0, 1), cB + hstep, voffB); PG8_STAGE(PG8_SA(0, 1), cA + hstep, voffA);
        if (wr == 1) PG8_BAR;
        PG8_WAIT_V(4); PG8_BAR;
        PG8_STAGE(PG8_SB(1, 0), cB + kstep, voffB); PG8_STAGE(PG8_SA(1, 0), cA + kstep, voffA); PG8_STAGE(PG8_SB(1, 1), cB + hstep + kstep, voffB);
        PG8_WAIT_V(6); PG8_BAR;
    }
    for (;;) {
        const bool has_next = S.next(ui + 1, nxt);
        const char* nA = has_next ? (const char*)g.A + (size_t)nxt.pm * tstep : cA; const char* nB = has_next ? (const char*)g.Bt + (size_t)nxt.pn * tstep : cB;
        for (int t = 0; t < nt; t += 2) {
            const bool last = (t == nt - 2);
            const char* a1 = cA + (size_t)(t + 1) * kstep;
            const char* a2 = last ? nA : cA + (size_t)(t + 2) * kstep; const char* b2 = last ? nB : cB + (size_t)(t + 2) * kstep;
            const char* a3 = a2 + kstep; const char* b3 = b2 + kstep;
            if (last && has_next) S.a_ready(nxt);
            if constexpr (SP2) {
            PG8_LDB(B0, 0, 0); PG8_LDB(B1, 0, 1); PG8_SCHED; PG8_LDA(At, 0, 0); PG8_STAGE(PG8_SA(1, 1), a1 + hstep, voffA);
            PG8_WAIT_V(8); PG8_WAIT_L(0); PG8_BAR; PG8_MMA(0, 0, At, B0); PG8_MMA(0, 1, At, B1); PG8_BAR; PG8_SCHED;
            PG8_LDA(At, 0, 1); PG8_STAGE(PG8_SB(0, 0), b2, voffB); PG8_STAGE(PG8_SB(0, 1), b2 + hstep, voffB); PG8_STAGE(PG8_SA(0, 0), a2, voffA);
            PG8_WAIT_V(8); PG8_WAIT_L(0); PG8_BAR; PG8_MMA(1, 0, At, B0); PG8_MMA(1, 1, At, B1); PG8_BAR; PG8_SCHED;
            PG8_LDB(B0, 1, 0); PG8_LDB(B1, 1, 1); PG8_SCHED; PG8_LDA(At, 1, 0); PG8_STAGE(PG8_SA(0, 1), a2 + hstep, voffA);
            PG8_WAIT_V(8); PG8_WAIT_L(0); PG8_BAR; PG8_MMA(0, 0, At, B0); PG8_MMA(0, 1, At, B1); PG8_BAR; PG8_SCHED;
            PG8_LDA(At, 1, 1); PG8_STAGE(PG8_SB(1, 0), b3, voffB); PG8_STAGE(PG8_SB(1, 1), b3 + hstep, voffB); PG8_STAGE(PG8_SA(1, 0), a3, voffA);
            PG8_WAIT_V(8); PG8_WAIT_L(0); PG8_BAR; PG8_MMA(1, 0, At, B0); PG8_MMA(1, 1, At, B1); PG8_BAR; PG8_SCHED;
            } else {
            PG8_LDB(B0, 0, 0); PG8_SCHED; PG8_LDA(At, 0, 0); PG8_STAGE(PG8_SA(1, 1), a1 + hstep, voffA);
            PG8_WAIT_L(8); PG8_BAR; PG8_WAIT_L(0); PG8_MMA(0, 0, At, B0); PG8_BAR; PG8_SCHED;
            PG8_LDB(B1, 0, 1); PG8_STAGE(PG8_SB(0, 0), b2, voffB);
            PG8_BAR; PG8_WAIT_L(0); PG8_MMA(0, 1, At, B1); PG8_BAR;
            PG8_LDA(At, 0, 1); PG8_STAGE(PG8_SA(0, 0), a2, voffA);
            PG8_BAR; PG8_WAIT_L(0); PG8_MMA(1, 0, At, B0); PG8_BAR; PG8_SCHED;
            PG8_STAGE(PG8_SB(0, 1), b2 + hstep, voffB);
            PG8_WAIT_V(6); PG8_BAR; PG8_MMA(1, 1, At, B1); PG8_BAR;
            PG8_LDB(B0, 1, 0); PG8_SCHED; PG8_LDA(At, 1, 0); PG8_STAGE(PG8_SA(0, 1), a2 + hstep, voffA);
            PG8_WAIT_L(8); PG8_BAR; PG8_WAIT_L(0); PG8_MMA(0, 0, At, B0); PG8_BAR; PG8_SCHED;
            PG8_LDB(B1, 1, 1); PG8_STAGE(PG8_SB(1, 0), b3, voffB);
            PG8_BAR; PG8_WAIT_L(0); PG8_MMA(0, 1, At, B1); PG8_BAR;
            PG8_LDA(At, 1, 1); PG8_STAGE(PG8_SA(1, 0), a3, voffA);
            PG8_BAR; PG8_WAIT_L(0); PG8_MMA(1, 0, At, B0); PG8_BAR; PG8_SCHED;
            PG8_STAGE(PG8_SB(1, 1), b3 + hstep, voffB);
            PG8_WAIT_V(6); PG8_BAR; PG8_MMA(1, 1, At, B1); PG8_BAR;
            }
        }
        if constexpr (ALIGN_EPI) { if (wr == 0) PG8_BAR; }
        if constexpr (!Epi::AFTER_DRAIN) { E(acc, cur, wr, wc, fr, fq); S.done(cur); }
        if (!has_next) break;
#pragma unroll
        for (int a = 0; a < 2; ++a)
#pragma unroll
            for (int b = 0; b < 2; ++b)
#pragma unroll
                for (int m = 0; m < 4; ++m)
#pragma unroll
                    for (int n = 0; n < 2; ++n) acc[a][b][m][n] = (f32x4){0.f, 0.f, 0.f, 0.f};
        cur = nxt; cA = nA; cB = nB; ++ui;
        if constexpr (ALIGN_EPI) { if (wr == 1) PG8_BAR; }
    }
    PG8_WAIT_V(0);
    if constexpr (!ALIGN_EPI) { if (wr == 0) PG8_BAR; }
    PG8_BAR;
    if constexpr (Epi::AFTER_DRAIN) { E.fused(acc, cur, wr, wc, fr, fq, lds, wid, lane); S.done(cur); }
#undef PG8_SA
#undef PG8_SB
#undef PG8_STAGE
#undef PG8_LDA
#undef PG8_LDB
#undef PG8_MMA
#undef PG8_WAIT_V
#undef PG8_WAIT_L
#undef PG8_BAR
#undef PG8_SCHED
}
}
namespace pg8 {
typedef float f32x2c __attribute__((ext_vector_type(2))); typedef __bf16 bf16x2c __attribute__((ext_vector_type(2)));
__device__ __forceinline__ unsigned cvt_pk_bf16(float lo, float hi) { f32x2c v = {lo, hi}; return __builtin_bit_cast(unsigned, __builtin_convertvector(v, bf16x2c)); }
struct EpiBf16 {
    static constexpr bool PERM = true, AFTER_DRAIN = false;
    bf16_t* O; int ldc;
    __device__ __forceinline__ void operator()(const f32x4 (&acc)[2][2][4][2], const Unit& u, int wr, int wc, int fr, int fq) const {
        const int row0 = u.pm * BM + wr * 64 + fr; const int col0 = u.pn * BM + wc * 32 + 8 * fq;
#pragma unroll
        for (int ai = 0; ai < 2; ++ai)
#pragma unroll
            for (int m = 0; m < 4; ++m) { bf16_t* rowp = O + (size_t)(row0 + ai * HALF + m * 16) * ldc + col0;
#pragma unroll
                for (int bj = 0; bj < 2; ++bj) { const f32x4 v0 = acc[ai][bj][m][0], v1 = acc[ai][bj][m][1];
                    u32x4 w; w.x = cvt_pk_bf16(v0[0], v0[1]); w.y = cvt_pk_bf16(v0[2], v0[3]); w.z = cvt_pk_bf16(v1[0], v1[1]); w.w = cvt_pk_bf16(v1[2], v1[3]);
                    *(u32x4*)(rowp + bj * HALF) = w; } }
    }
};
struct EpiSwiglu {
    static constexpr bool PERM = true, AFTER_DRAIN = false;
    bf16_t* O; int ldc;
    __device__ __forceinline__ void operator()(const f32x4 (&acc)[2][2][4][2], const Unit& u, int wr, int wc, int fr, int fq) const {
        const int row0 = u.pm * BM + wr * 64 + fr; const int col0 = u.pn * HALF + wc * 32 + 8 * fq;
#pragma unroll
        for (int ai = 0; ai < 2; ++ai)
#pragma unroll
            for (int m = 0; m < 4; ++m) { bf16_t* rowp = O + (size_t)(row0 + ai * HALF + m * 16) * ldc + col0;
                float h[8];
#pragma unroll
                for (int n = 0; n < 2; ++n)
#pragma unroll
                    for (int j = 0; j < 4; ++j) { const float g = acc[ai][0][m][n][j], up = acc[ai][1][m][n][j];
                        h[n * 4 + j] = g * __builtin_amdgcn_rcpf(1.0f + __expf(-g)) * up; }
                u32x4 w; w.x = cvt_pk_bf16(h[0], h[1]); w.y = cvt_pk_bf16(h[2], h[3]); w.z = cvt_pk_bf16(h[4], h[5]); w.w = cvt_pk_bf16(h[6], h[7]);
                *(u32x4*)rowp = w; }
    }
};
struct EpiResid {
    static constexpr bool PERM = false, AFTER_DRAIN = false;
    const float* base; float* Z; int ldc; float alpha, beta;
    __device__ __forceinline__ void operator()(const f32x4 (&acc)[2][2][4][2], const Unit& u, int wr, int wc, int fr, int fq) const {
        const int row0 = u.pm * BM + wr * 64 + fr, col0 = u.pn * BM + wc * 32 + 4 * fq;
#pragma unroll
        for (int ai = 0; ai < 2; ++ai)
#pragma unroll
            for (int m = 0; m < 4; ++m) { const size_t off = (size_t)(row0 + ai * HALF + m * 16) * ldc + col0;
#pragma unroll
                for (int bj = 0; bj < 2; ++bj)
#pragma unroll
                    for (int n = 0; n < 2; ++n) { const f32x4 bs = *(const f32x4*)(base + off + bj * HALF + n * 16);
                        *(f32x4*)(Z + off + bj * HALF + n * 16) = bs * alpha + acc[ai][bj][m][n] * beta; } }
    }
};
}
constexpr int BATCH = 2, T = 4096, D = 2048, DEPTH = 4, M = BATCH * T;
constexpr int FF = 5504, NGU = 2 * FF;
constexpr int NIN = 5664, NINP = 5888;
constexpr int GH = 4, GK = 96, GV = 192, GDK = 384, GDV = 768, GR = 16, GC = 64, NCH = T / GC;
constexpr int DH = 6, DE = 128, DD = 768;
constexpr int CC = 512, CK = 31;
constexpr int PC_GQ = 0, PC_GK = 384, PC_GV = 768, PC_GG = 1536, PC_DQ = 2304, PC_DK = 3072, PC_DV = 3840, PC_CVAL = 4608, PC_CGATE = 5120, PC_RF = 5632, PC_RB = 5648;
constexpr float LN_EPS = 1e-5f;
constexpr float DN_ALPHA = 1.6817928305074290f;
constexpr size_t MiB = 1u << 20;
constexpr size_t WS_CTL = 0, CTL_ZERO_BYTES = 65536;
constexpr size_t WS_W = 1 * MiB;
constexpr size_t WO_GU1 = 0, WO_D1 = 43 * MiB, WO_IN = WO_D1 + 43 * MiB / 2, WO_OUT = WO_IN + 23 * MiB, WO_GU2 = WO_OUT + 8 * MiB, WO_D2 = WO_GU2 + 43 * MiB, W_LAYER = WO_D2 + 43 * MiB / 2;
static_assert(W_LAYER == 160 * MiB, "weights per layer");
constexpr size_t WS_XF = WS_W + W_LAYER;
constexpr size_t WS_Z = WS_XF + 64 * MiB;
constexpr size_t WS_XB = WS_Z + 64 * MiB;
constexpr size_t WS_CAT = WS_XB + 32 * MiB;
constexpr size_t WS_HP = WS_CAT + 32 * MiB;
constexpr size_t WS_U = WS_HP + 92 * MiB;
constexpr size_t WS_LAF = WS_U + 72 * MiB;
constexpr size_t WS_LAB = WS_LAF + 12 * MiB;
constexpr size_t WS_DEC = WS_LAB + 12 * MiB;
constexpr size_t WS_OP = WS_DEC + 1 * MiB;
constexpr size_t WS_LSE = WS_OP + 72 * MiB;
constexpr size_t WS_END = WS_LSE + 1 * MiB;
static_assert(WS_END <= 700 * MiB, "workspace");
constexpr int CW_BAR = 1024;
constexpr int RING_BYTES = 131072, LDS_BYTES = 147456, MISC_OFF = LDS_BYTES - 256;
constexpr int NWAVES = 8, NTHR = 512;

#define GAS __attribute__((address_space(1)))
#define LAS __attribute__((address_space(3)))
typedef unsigned short bf16;
typedef unsigned v4u __attribute__((ext_vector_type(4)));
typedef unsigned v2u __attribute__((ext_vector_type(2)));
typedef float f32x4 __attribute__((ext_vector_type(4)));
#define LDS_WAIT() asm volatile("s_waitcnt lgkmcnt(0)" ::: "memory")
typedef float f32x2_t __attribute__((ext_vector_type(2)));
typedef __bf16 bf16x2_t __attribute__((ext_vector_type(2)));
__device__ __forceinline__ unsigned pk2(float lo, float hi) { f32x2_t v = {lo, hi}; return __builtin_bit_cast(unsigned, __builtin_convertvector(v, bf16x2_t)); }
__device__ __forceinline__ unsigned f2bf(float f) { return (unsigned)__builtin_bit_cast(unsigned short, (__bf16)f); }
__device__ __forceinline__ float bflo(unsigned w) { return __builtin_bit_cast(float, w << 16); }
__device__ __forceinline__ float bfhi(unsigned w) { return __builtin_bit_cast(float, w & 0xffff0000u); }
__device__ __forceinline__ float bf2f(bf16 b) { return __builtin_bit_cast(float, ((unsigned)b) << 16); }
__device__ __forceinline__ float wave_sum(float v) {
#pragma unroll
    for (int o = 1; o < 64; o <<= 1) v += __shfl_xor(v, o);
    return v;
}
#define XB_TMO      128
#define XB_XCNT(j)  (256  + 64 * (j))
#define XB_XSUB(j)  (1280 + 64 * (j))
#define XB_XGEN(j)  (2304 + 64 * (j))
#define XB_TOP      3328
#define XB_TOPGEN   3392
#define XCD_BAR_WORDS 3456
#define XB_SPIN_CAP (1u << 18)

__device__ __forceinline__ unsigned xb_ld(unsigned* p)              { return __hip_atomic_load(p, __ATOMIC_RELAXED, __HIP_MEMORY_SCOPE_AGENT); }
__device__ __forceinline__ unsigned xb_add(unsigned* p, unsigned v) { return __hip_atomic_fetch_add(p, v, __ATOMIC_RELAXED, __HIP_MEMORY_SCOPE_AGENT); }
__device__ __forceinline__ unsigned xb_xcc_id() { return (unsigned)__builtin_amdgcn_s_getreg((3 << 11) | 20) & 0xFu; }
#define XB_SPIN(cond, bar) do { unsigned _sp = 0; while (cond) { __builtin_amdgcn_s_sleep(1); \
    if ((++_sp & 255u) == 0u) { if (xb_ld(&(bar)[XB_TMO])) break; if (_sp > XB_SPIN_CAP) { atomicAdd(&(bar)[XB_TMO], 1u); break; } } } } while (0)

struct XcdBarrier {
    unsigned* bar; unsigned x;
    volatile LAS unsigned* st;
};

__device__ __forceinline__ XcdBarrier xcd_barrier_post(unsigned* bar, volatile LAS unsigned* st) {
    XcdBarrier b; b.bar = bar; b.x = xb_xcc_id(); b.st = st;
    if (threadIdx.x == 0) (void)xb_add(&bar[XB_XCNT(b.x)], 1u);
    return b;
}
__device__ __forceinline__ void xcd_barrier_complete(unsigned* bar, unsigned x, unsigned& nloc, unsigned& nx) {
    const unsigned G = gridDim.x * gridDim.y * gridDim.z;
    unsigned sum, cnt, mine, sp = 0u;
    for (;;) {
        sum = 0u; cnt = 0u; mine = 0u;
#pragma unroll
        for (unsigned j = 0; j < 16; ++j) { const unsigned c = xb_ld(&bar[XB_XCNT(j)]); sum += c; cnt += (c > 0u) ? 1u : 0u; mine = (j == x) ? c : mine; }
        if (sum == G) break;
        __builtin_amdgcn_s_sleep(1);
        if ((++sp & 255u) == 0u) { if (xb_ld(&bar[XB_TMO])) break; if (sp > XB_SPIN_CAP) { atomicAdd(&bar[XB_TMO], 1u); break; } }
    }
    nloc = mine > 0u ? mine : 1u; nx = cnt > 0u ? cnt : 1u;
}

__device__ __forceinline__ void xcd_barrier(const XcdBarrier& b) {
    asm volatile("s_waitcnt vmcnt(0)" ::: "memory");
    __syncthreads();
    if (threadIdx.x == 0) {
        unsigned* bar = b.bar;
        __builtin_amdgcn_s_waitcnt(0);
        unsigned nloc = b.st[0], nx = b.st[1];
        if (nloc == 0u) { xcd_barrier_complete(bar, b.x, nloc, nx); b.st[0] = nloc; b.st[1] = nx; }
        const unsigned old = xb_add(&bar[XB_XSUB(b.x)], 1u);
        const unsigned gen = old / nloc;
        if (old + 1u == (gen + 1u) * nloc) {
            __builtin_amdgcn_fence(__ATOMIC_RELEASE, "agent");
            asm volatile("s_waitcnt vmcnt(0)" ::: "memory");
            const unsigned og = xb_add(&bar[XB_TOP], 1u);
            const unsigned tg = og / nx;
            if (og + 1u == (tg + 1u) * nx) xb_add(&bar[XB_TOPGEN], 1u);
            else XB_SPIN(xb_ld(&bar[XB_TOPGEN]) == tg, bar);
            __builtin_amdgcn_fence(__ATOMIC_ACQUIRE, "agent");
            xb_add(&bar[XB_XGEN(b.x)], 1u);
            asm volatile("s_waitcnt vmcnt(0)" ::: "memory");
        } else {
            XB_SPIN(xb_ld(&bar[XB_XGEN(b.x)]) == gen, bar);
            __builtin_amdgcn_fence(__ATOMIC_ACQUIRE, "agent");
            asm volatile("s_waitcnt vmcnt(0)" ::: "memory");
        }
    }
    __syncthreads();
}
__device__ __forceinline__ void tr_item(const float* W, int N, bf16* WT, int K, int k0, int n0, int drow0, LAS float* scr, int lane) {
#pragma unroll 8
    for (int i = 0; i < 32; ++i) { const int kk = 2 * i + (lane >> 5); scr[kk * 33 + (lane & 31)] = W[(size_t)(k0 + kk) * N + n0 + (lane & 31)]; }
    LDS_WAIT(); asm volatile("" ::: "memory");
    const int c = lane & 7;
#pragma unroll
    for (int j = 0; j < 4; ++j) { const int n = (lane >> 3) + 8 * j; const LAS float* s = scr + (8 * c) * 33 + n;
        v4u o; o.x = pk2(s[0 * 33], s[1 * 33]); o.y = pk2(s[2 * 33], s[3 * 33]); o.z = pk2(s[4 * 33], s[5 * 33]); o.w = pk2(s[6 * 33], s[7 * 33]);
        *(GAS v4u*)(WT + (size_t)(drow0 + n) * K + k0 + 8 * c) = o; }
    LDS_WAIT(); asm volatile("" ::: "memory");
}
struct LayerW { const float *g1, *u1, *d1, *win, *wout, *g2, *u2, *d2; };
__device__ __forceinline__ void convert_phase(const LayerW& w, unsigned char* wsw, LAS unsigned char* lds, int bid, int G, int wave, int lane, int tid) {
    LAS float* scr = (LAS float*)(lds + wave * 16384);
    const int gw = bid * NWAVES + wave, NGW = G * NWAVES;
    constexpr int I_GU = (D / 64) * (FF / 32), I_DN = (FF / 64) * (D / 32), I_IN = (D / 64) * (NIN / 32), I_OUT = (D / 64) * (D / 32);
    constexpr int NITEMS = 6 * I_GU + I_IN + I_OUT; static_assert(I_GU == I_DN, "items");
    bf16* WGU1 = (bf16*)(wsw + WO_GU1); bf16* WD1 = (bf16*)(wsw + WO_D1); bf16* WIN = (bf16*)(wsw + WO_IN); bf16* WOUT = (bf16*)(wsw + WO_OUT); bf16* WGU2 = (bf16*)(wsw + WO_GU2); bf16* WD2 = (bf16*)(wsw + WO_D2);
    for (int it = gw; it < NITEMS; it += NGW) {
        int r = it;
        if (r < 4 * I_GU) {
            const int which = r / I_GU; r -= which * I_GU; const int nblk = FF / 32, kb = r / nblk, nb = r % nblk, n0 = 32 * nb;
            const float* W = which == 0 ? w.g1 : which == 1 ? w.u1 : which == 2 ? w.g2 : w.u2;
            tr_item(W, FF, which < 2 ? WGU1 : WGU2, D, 64 * kb, n0, 256 * (n0 / 128) + 128 * (which & 1) + (n0 % 128), scr, lane); continue; }
        r -= 4 * I_GU;
        if (r < 2 * I_DN) { const int which = r / I_DN; r -= which * I_DN; const int nblk = D / 32, kb = r / nblk, nb = r % nblk;
            tr_item(which ? w.d2 : w.d1, D, which ? WD2 : WD1, FF, 64 * kb, 32 * nb, 32 * nb, scr, lane); continue; }
        r -= 2 * I_DN;
        if (r < I_IN) { const int nblk = NIN / 32, kb = r / nblk, nb = r % nblk, n0 = 32 * nb;
            const int drow = n0 < 1536 ? n0 : (n0 == 1536 ? PC_RF : n0 - 32);
            tr_item(w.win, NIN, WIN, D, 64 * kb, n0, drow, scr, lane); continue; }
        r -= I_IN;
        { const int nblk = D / 32, kb = r / nblk, nb = r % nblk; tr_item(w.wout, D, WOUT, D, 64 * kb, 32 * nb, 32 * nb, scr, lane); }
    }
    { GAS v4u* p = (GAS v4u*)(WIN + (size_t)NIN * D); const int n16 = (NINP - NIN) * D / 8; const v4u z = {0u, 0u, 0u, 0u};
      for (int i = bid * NTHR + tid; i < n16; i += G * NTHR) p[i] = z; }
}
__device__ __forceinline__ void cast_phase(const float* x, bf16* XB, int bid, int G, int tid) {
    const GAS f32x4* s = (const GAS f32x4*)x; GAS v2u* d = (GAS v2u*)XB;
    for (int i = bid * NTHR + tid; i < M * D / 4; i += G * NTHR) { const f32x4 v = s[i]; v2u o; o.x = pk2(v.x, v.y); o.y = pk2(v.z, v.w); d[i] = o; }
}
__device__ __forceinline__ void ln_phase(const float* Z, const float* g, const float* b, float* XF, bf16* XB, int bid, int G, int wave, int lane) {
    const int gw = bid * NWAVES + wave, NGW = G * NWAVES;
    for (int m = gw; m < M; m += NGW) {
        const GAS f32x4* zr = (const GAS f32x4*)(Z + (size_t)m * D) + lane;
        f32x4 v[8]; float s = 0.f;
#pragma unroll
        for (int j = 0; j < 8; ++j) { v[j] = zr[64 * j]; s += (v[j].x + v[j].y) + (v[j].z + v[j].w); }
        const float mean = wave_sum(s) * (1.f / D); float s2 = 0.f;
#pragma unroll
        for (int j = 0; j < 8; ++j) { v[j] = v[j] - mean; s2 += (v[j].x * v[j].x + v[j].y * v[j].y) + (v[j].z * v[j].z + v[j].w * v[j].w); }
        const float rstd = 1.f / sqrtf(wave_sum(s2) * (1.f / D) + LN_EPS);
        GAS f32x4* xo = (GAS f32x4*)(XF + (size_t)m * D) + lane; GAS v2u* bo = (GAS v2u*)(XB + (size_t)m * D) + lane;
#pragma unroll
        for (int j = 0; j < 8; ++j) { const f32x4 gg = ((const GAS f32x4*)g)[lane + 64 * j], bb = ((const GAS f32x4*)b)[lane + 64 * j];
            const f32x4 o = v[j] * rstd * gg + bb; xo[64 * j] = o; v2u w; w.x = pk2(o.x, o.y); w.y = pk2(o.z, o.w); bo[64 * j] = w; }
    }
}

constexpr int DIL_PITCH = 136;
__device__ __forceinline__ void dil_item(int item, const bf16* PROJ, float* OP, float* LSE, LAS unsigned char* lds, int tid) {
    const int tt = item & 63; int r3 = item >> 6; const int br = r3 % 3; r3 /= 3; const int h = r3 % DH, b = r3 / DH;
    const int d = br == 0 ? 1 : (br == 1 ? 4 : 16), tpr = 64 / d, res = tt / tpr, i0 = (tt % tpr) * 64, L = T / d;
    LAS bf16* Ks = (LAS bf16*)lds; LAS bf16* Vs = Ks + 192 * DIL_PITCH;
    const bf16* base = PROJ + (size_t)b * T * NINP;
    for (int c = tid; c < 192 * 16; c += NTHR) { const int row = c >> 4, ch = c & 15, i = i0 - 64 + row;
        v4u kv = {0u, 0u, 0u, 0u}, vv = {0u, 0u, 0u, 0u};
        if (i >= 0 && i < L) { const bf16* rp = base + (size_t)(res + d * i) * NINP + h * DE + ch * 8; kv = *(const GAS v4u*)(rp + PC_DK); vv = *(const GAS v4u*)(rp + PC_DV); }
        *(LAS v4u*)(Ks + row * DIL_PITCH + ch * 8) = kv; *(LAS v4u*)(Vs + row * DIL_PITCH + ch * 8) = vv; }
    const int qi = tid >> 3, e = tid & 7, tq = res + d * (i0 + qi);
    float q[16];
    { const bf16* qp = base + (size_t)tq * NINP + PC_DQ + h * DE + e * 16; const v4u a = *(const GAS v4u*)qp, c = *(const GAS v4u*)(qp + 8);
      q[0] = bflo(a.x); q[1] = bfhi(a.x); q[2] = bflo(a.y); q[3] = bfhi(a.y); q[4] = bflo(a.z); q[5] = bfhi(a.z); q[6] = bflo(a.w); q[7] = bfhi(a.w);
      q[8] = bflo(c.x); q[9] = bfhi(c.x); q[10] = bflo(c.y); q[11] = bfhi(c.y); q[12] = bflo(c.z); q[13] = bfhi(c.z); q[14] = bflo(c.w); q[15] = bfhi(c.w); }
    __syncthreads();
    const float slope = exp2f(-8.0f * (float)(h + 1) / (float)DH) * (float)d, scale = 0.08838834764831845f;
    float mx = -1e30f, l = 0.f, acc[16];
#pragma unroll
    for (int x = 0; x < 16; ++x) acc[x] = 0.f;
    for (int jj = 0; jj <= 128; ++jj) {
        const int kr = qi + jj, i = i0 - 64 + kr;
        const LAS bf16* kp = Ks + kr * DIL_PITCH + e * 16; const v4u a = *(const LAS v4u*)kp, c = *(const LAS v4u*)(kp + 8);
        float dot = q[0] * bflo(a.x) + q[1] * bfhi(a.x) + q[2] * bflo(a.y) + q[3] * bfhi(a.y) + q[4] * bflo(a.z) + q[5] * bfhi(a.z) + q[6] * bflo(a.w) + q[7] * bfhi(a.w)
                  + q[8] * bflo(c.x) + q[9] * bfhi(c.x) + q[10] * bflo(c.y) + q[11] * bfhi(c.y) + q[12] * bflo(c.z) + q[13] * bfhi(c.z) + q[14] * bflo(c.w) + q[15] * bfhi(c.w);
        dot += __shfl_xor(dot, 1); dot += __shfl_xor(dot, 2); dot += __shfl_xor(dot, 4);
        if (i >= 0 && i < L) {
            const int aj = jj < 64 ? 64 - jj : jj - 64;
            const float s = dot * scale - slope * (float)aj, mn = fmaxf(mx, s), corr = __expf(mx - mn), p = __expf(s - mn);
            const LAS bf16* vp = Vs + kr * DIL_PITCH + e * 16; const v4u va = *(const LAS v4u*)vp, vc = *(const LAS v4u*)(vp + 8);
            l = l * corr + p; mx = mn;
            acc[0] = acc[0] * corr + p * bflo(va.x); acc[1] = acc[1] * corr + p * bfhi(va.x); acc[2] = acc[2] * corr + p * bflo(va.y); acc[3] = acc[3] * corr + p * bfhi(va.y);
            acc[4] = acc[4] * corr + p * bflo(va.z); acc[5] = acc[5] * corr + p * bfhi(va.z); acc[6] = acc[6] * corr + p * bflo(va.w); acc[7] = acc[7] * corr + p * bfhi(va.w);
            acc[8] = acc[8] * corr + p * bflo(vc.x); acc[9] = acc[9] * corr + p * bfhi(vc.x); acc[10] = acc[10] * corr + p * bflo(vc.y); acc[11] = acc[11] * corr + p * bfhi(vc.y);
            acc[12] = acc[12] * corr + p * bflo(vc.z); acc[13] = acc[13] * corr + p * bfhi(vc.z); acc[14] = acc[14] * corr + p * bflo(vc.w); acc[15] = acc[15] * corr + p * bfhi(vc.w);
        }
    }
    const float inv = 1.f / l; const size_t tok = (size_t)b * T + tq;
    GAS f32x4* op = (GAS f32x4*)(OP + ((size_t)br * M + tok) * DD + h * DE + e * 16);
#pragma unroll
    for (int x = 0; x < 4; ++x) op[x] = (f32x4){acc[4 * x] * inv, acc[4 * x + 1] * inv, acc[4 * x + 2] * inv, acc[4 * x + 3] * inv};
    if (e == 0) LSE[((size_t)br * M + tok) * DH + h] = mx + __logf(l);
    __syncthreads();
}
__device__ __forceinline__ void dil_merge_item(int item, const float* OP, const float* LSE, bf16* CAT, int tid) {
    for (int e = tid; e < 32 * (DD / 4); e += NTHR) { const int tk = e / (DD / 4), c4 = e % (DD / 4), col = 4 * c4, h = col / DE; const size_t tok = (size_t)item * 32 + tk;
        const float l0 = LSE[((size_t)0 * M + tok) * DH + h], l1 = LSE[((size_t)1 * M + tok) * DH + h], l2 = LSE[((size_t)2 * M + tok) * DH + h];
        const float mm = fmaxf(l0, fmaxf(l1, l2)), w0 = __expf(l0 - mm), w1 = __expf(l1 - mm), w2 = __expf(l2 - mm), inv = 1.f / (w0 + w1 + w2);
        const f32x4 a = *(const GAS f32x4*)(OP + ((size_t)0 * M + tok) * DD + col), bq = *(const GAS f32x4*)(OP + ((size_t)1 * M + tok) * DD + col), c = *(const GAS f32x4*)(OP + ((size_t)2 * M + tok) * DD + col);
        const f32x4 o = (a * w0 + bq * w1 + c * w2) * inv; v2u w; w.x = pk2(o.x, o.y); w.y = pk2(o.z, o.w);
        *(GAS v2u*)(CAT + tok * D + GDV + col) = w; }
}
__device__ __forceinline__ void conv_item(int item, const bf16* PROJ, const float* cw, const float* cb, const float* lg, const float* lb, bf16* CAT, LAS unsigned char* lds, int tid, int wave, int lane) {
    const int b = item / (T / 32), t0 = (item % (T / 32)) * 32;
    LAS float* us = (LAS float*)lds;
    for (int c = tid; c < 62 * 64; c += NTHR) { const int rr = c >> 6, ch = c & 63, t = t0 - 15 + rr; float u[8];
        if (t >= 0 && t < T) { const bf16* rp = PROJ + ((size_t)b * T + t) * NINP + ch * 8; const v4u a = *(const GAS v4u*)(rp + PC_CVAL), g = *(const GAS v4u*)(rp + PC_CGATE);
            const float av[8] = {bflo(a.x), bfhi(a.x), bflo(a.y), bfhi(a.y), bflo(a.z), bfhi(a.z), bflo(a.w), bfhi(a.w)}, gv[8] = {bflo(g.x), bfhi(g.x), bflo(g.y), bfhi(g.y), bflo(g.z), bfhi(g.z), bflo(g.w), bfhi(g.w)};
#pragma unroll
            for (int x = 0; x < 8; ++x) u[x] = av[x] / (1.f + __expf(-gv[x]));
        } else {
#pragma unroll
            for (int x = 0; x < 8; ++x) u[x] = 0.f; }
        *(LAS f32x4*)(us + rr * CC + ch * 8) = (f32x4){u[0], u[1], u[2], u[3]}; *(LAS f32x4*)(us + rr * CC + ch * 8 + 4) = (f32x4){u[4], u[5], u[6], u[7]}; }
    __syncthreads();
    float y[32];
    { const int c = tid; const float bias = cb[c];
#pragma unroll
      for (int tk = 0; tk < 32; ++tk) y[tk] = bias;
      for (int j = 0; j < CK; ++j) { const float wj = cw[j * CC + c];
#pragma unroll
          for (int tk = 0; tk < 32; ++tk) y[tk] += us[(tk + j) * CC + c] * wj; } }
    __syncthreads();
#pragma unroll
    for (int tk = 0; tk < 32; ++tk) us[tk * CC + tid] = y[tk];
    __syncthreads();
    for (int q = 0; q < 4; ++q) { const int tk = wave * 4 + q; const LAS float* yr = us + tk * CC + lane * 8; float v[8]; float s = 0.f;
#pragma unroll
        for (int x = 0; x < 8; ++x) { v[x] = yr[x]; s += v[x]; }
        const float mean = wave_sum(s) * (1.f / CC); float s2 = 0.f;
#pragma unroll
        for (int x = 0; x < 8; ++x) { v[x] -= mean; s2 += v[x] * v[x]; }
        const float rstd = 1.f / sqrtf(wave_sum(s2) * (1.f / CC) + LN_EPS); float o[8];
#pragma unroll
        for (int x = 0; x < 8; ++x) { const float z = v[x] * rstd * lg[lane * 8 + x] + lb[lane * 8 + x]; o[x] = z / (1.f + __expf(-z)); }
        v4u w; w.x = pk2(o[0], o[1]); w.y = pk2(o[2], o[3]); w.z = pk2(o[4], o[5]); w.w = pk2(o[6], o[7]);
        *(GAS v4u*)(CAT + ((size_t)b * T + t0 + tk) * D + GDV + DD + lane * 8) = w; }
    __syncthreads();
}
__device__ __forceinline__ void gla1_item(int item, const bf16* PROJ, const float* wf, const float* bf_, const float* wb, const float* bb_, float* U, float* LAF, float* LAB, float* DEC, LAS unsigned char* lds, int tid) {
    const int h = item & 3, n = (item >> 2) & 63, b = item >> 8; const size_t tok0 = (size_t)b * T + (size_t)n * GC;
    LAS float* kk = (LAS float*)lds; LAS float* vv = kk + 64 * 96; LAS float* cf = vv + 64 * 192; LAS float* cb = cf + 64 * 96; LAS float* rf = cb + 64 * 96; LAS float* rb = rf + 64 * 16;
    for (int c = tid; c < 64 * 12; c += NTHR) { const int row = c / 12, ch = c % 12; const v4u a = *(const GAS v4u*)(PROJ + (tok0 + row) * NINP + PC_GK + h * GK + ch * 8); LAS float* o = kk + row * 96 + ch * 8;
        o[0] = bflo(a.x); o[1] = bfhi(a.x); o[2] = bflo(a.y); o[3] = bfhi(a.y); o[4] = bflo(a.z); o[5] = bfhi(a.z); o[6] = bflo(a.w); o[7] = bfhi(a.w); }
    for (int c = tid; c < 64 * 24; c += NTHR) { const int row = c / 24, ch = c % 24; const v4u a = *(const GAS v4u*)(PROJ + (tok0 + row) * NINP + PC_GV + h * GV + ch * 8); LAS float* o = vv + row * 192 + ch * 8;
        o[0] = bflo(a.x); o[1] = bfhi(a.x); o[2] = bflo(a.y); o[3] = bfhi(a.y); o[4] = bflo(a.z); o[5] = bfhi(a.z); o[6] = bflo(a.w); o[7] = bfhi(a.w); }
    for (int c = tid; c < 64 * 32; c += NTHR) { const int row = c >> 5, x = c & 31; const float v = bf2f(PROJ[(tok0 + row) * NINP + PC_RF + x]); if (x < 16) rf[row * 16 + x] = v; else rb[row * 16 + x - 16] = v; }
    __syncthreads();
    for (int idx = tid; idx < 64 * 96; idx += NTHR) { const int c = idx / 96, k = idx % 96, hk = h * GK + k; float zf = bf_[hk], zb = bb_[hk];
#pragma unroll
        for (int r = 0; r < 16; ++r) { zf += rf[c * 16 + r] * wf[r * GDK + hk]; zb += rb[c * 16 + r] * wb[r * GDK + hk]; }
        cf[idx] = (fminf(zf, 0.f) - log1pf(expf(-fabsf(zf)))) * (1.f / 16.f); cb[idx] = (fminf(zb, 0.f) - log1pf(expf(-fabsf(zb)))) * (1.f / 16.f); }
    __syncthreads();
    if (tid < 96) { float run = 0.f;
#pragma unroll 4
        for (int c = 0; c < 64; ++c) { run += cf[c * 96 + tid]; cf[c * 96 + tid] = run; } }
    else if (tid < 192) { const int k = tid - 96; float run = 0.f;
#pragma unroll 4
        for (int c = 63; c >= 0; --c) { run += cb[c * 96 + k]; cb[c * 96 + k] = run; } }
    __syncthreads();
    for (int idx = tid; idx < 64 * 96; idx += NTHR) { const int c = idx / 96, k = idx % 96; LAF[(tok0 + c) * GDK + h * GK + k] = cf[idx]; LAB[(tok0 + c) * GDK + h * GK + k] = cb[idx]; }
    const size_t cid = ((size_t)(b * NCH + n) * GH + h) * 2;
    if (tid < 96) DEC[(cid + 0) * GK + tid] = __expf(cf[63 * 96 + tid]); else if (tid < 192) DEC[(cid + 1) * GK + tid - 96] = __expf(cb[tid - 96]);
    __syncthreads();
    if (tid < 96) { const float e = cf[63 * 96 + tid];
#pragma unroll 4
        for (int s = 0; s < 64; ++s) cf[s * 96 + tid] = kk[s * 96 + tid] * __expf(e - cf[s * 96 + tid]); }
    else if (tid < 192) { const int k = tid - 96; const float e = cb[k];
#pragma unroll 4
        for (int s = 63; s >= 0; --s) cb[s * 96 + k] = kk[s * 96 + k] * __expf(e - cb[s * 96 + k]); }
    __syncthreads();
#pragma unroll 1
    for (int j = 0; j < 36; ++j) { const int o = tid + NTHR * j, k = o / 192, v = o % 192; float af = 0.f, ab = 0.f;
#pragma unroll 8
        for (int s = 0; s < 64; ++s) { const float x = vv[s * 192 + v]; af += cf[s * 96 + k] * x; ab += cb[s * 96 + k] * x; }
        U[(cid + 0) * (GK * GV) + o] = af; U[(cid + 1) * (GK * GV) + o] = ab; }
    __syncthreads();
}
__device__ __forceinline__ void gla2_phase(float* U, const float* DEC, int bid, int G, int tid) {
    for (int e = bid * NTHR + tid; e < BATCH * GH * 2 * GK * GV; e += G * NTHR) {
        const int kv = e % (GK * GV); int r = e / (GK * GV); const int dir = r & 1; r >>= 1; const int h = r % GH, b = r / GH, k = kv / GV; float S = 0.f;
        for (int st = 0; st < NCH; ++st) { const int n = dir ? NCH - 1 - st : st; const size_t cid = ((size_t)(b * NCH + n) * GH + h) * 2 + dir;
            const float u = U[cid * (GK * GV) + kv], dc = DEC[cid * GK + k]; U[cid * (GK * GV) + kv] = S; S = dc * S + u; }
    }
}
__device__ __forceinline__ void gla3_item(int item, const bf16* PROJ, const float* U, const float* LAF, const float* LAB, const float* gn, bf16* CAT, LAS unsigned char* lds, int tid, int wave, int lane) {
    const int h = item & 3, n = (item >> 2) & 63, b = item >> 8; const size_t tok0 = (size_t)b * T + (size_t)n * GC;
    LAS float* qdT = (LAS float*)lds; LAS float* kiT = qdT + 96 * 64; LAS float* vv = kiT + 96 * 64; LAS float* attT = vv + 64 * 192; LAS float* obuf = qdT;
    for (int c = tid; c < 64 * 24; c += NTHR) { const int row = c / 24, ch = c % 24; const v4u a = *(const GAS v4u*)(PROJ + (tok0 + row) * NINP + PC_GV + h * GV + ch * 8); LAS float* o = vv + row * 192 + ch * 8;
        o[0] = bflo(a.x); o[1] = bfhi(a.x); o[2] = bflo(a.y); o[3] = bfhi(a.y); o[4] = bflo(a.z); o[5] = bfhi(a.z); o[6] = bflo(a.w); o[7] = bfhi(a.w); }
    const int v = tid % 192, cg = tid / 192;
    float acc[32];
#pragma unroll
    for (int i = 0; i < 32; ++i) acc[i] = 0.f;
    const size_t cid = ((size_t)(b * NCH + n) * GH + h) * 2;
    for (int dir = 0; dir < 2; ++dir) {
        const float* LA = dir ? LAB : LAF;
        for (int idx = tid; idx < 64 * 96; idx += NTHR) { const int c = idx / 96, k = idx % 96; const float bc = LA[(tok0 + c) * GDK + h * GK + k];
            const float qv = bf2f(PROJ[(tok0 + c) * NINP + PC_GQ + h * GK + k]), kv = bf2f(PROJ[(tok0 + c) * NINP + PC_GK + h * GK + k]);
            qdT[k * 64 + c] = qv * 0.10206207261596577f * __expf(bc); kiT[k * 64 + c] = kv * __expf(-bc); }
        __syncthreads();
        for (int j = 0; j < 8; ++j) { const int idx = tid + NTHR * j, s = idx >> 6, c = idx & 63; float a = 0.f;
            if (dir ? (s >= c) : (s <= c)) { for (int k = 0; k < 96; ++k) a += qdT[k * 64 + c] * kiT[k * 64 + s]; }
            attT[s * 64 + c] = a; }
        __syncthreads();
        if (tid < 384) {
            for (int s = 0; s < 64; ++s) { const float x = vv[s * 192 + v]; const LAS f32x4* ap = (const LAS f32x4*)(attT + s * 64 + 32 * cg);
#pragma unroll
                for (int i = 0; i < 8; ++i) { const f32x4 a = ap[i]; acc[4 * i] += a.x * x; acc[4 * i + 1] += a.y * x; acc[4 * i + 2] += a.z * x; acc[4 * i + 3] += a.w * x; } }
            const float* Sp = U + (cid + dir) * (GK * GV) + v;
            for (int k = 0; k < 96; ++k) { const float x = Sp[k * GV]; const LAS f32x4* qp = (const LAS f32x4*)(qdT + k * 64 + 32 * cg);
#pragma unroll
                for (int i = 0; i < 8; ++i) { const f32x4 a = qp[i]; acc[4 * i] += a.x * x; acc[4 * i + 1] += a.y * x; acc[4 * i + 2] += a.z * x; acc[4 * i + 3] += a.w * x; } }
        }
        __syncthreads();
    }
    if (tid < 384) {
#pragma unroll
        for (int i = 0; i < 32; ++i) obuf[(32 * cg + i) * 192 + v] = acc[i]; }
    __syncthreads();
    for (int cc = 0; cc < 8; ++cc) { const int c = wave * 8 + cc; float x[3], ss = 0.f;
#pragma unroll
        for (int j = 0; j < 3; ++j) { x[j] = obuf[c * 192 + lane + 64 * j]; ss += x[j] * x[j]; }
        const float r = 1.f / sqrtf(wave_sum(ss) * (1.f / GV) + LN_EPS);
#pragma unroll
        for (int j = 0; j < 3; ++j) { const int vc = lane + 64 * j; const float g = bf2f(PROJ[(tok0 + c) * NINP + PC_GG + h * GV + vc]);
            const float o = x[j] * r * gn[h * GV + vc] * (g / (1.f + __expf(-g))); CAT[(tok0 + c) * D + h * GV + vc] = (bf16)f2bf(o); } }
    __syncthreads();
}
typedef short bf16x8 __attribute__((ext_vector_type(8)));
#define MFMA16(a, b, c) __builtin_amdgcn_mfma_f32_16x16x32_bf16((a), (b), (c), 0, 0, 0)
__device__ __forceinline__ unsigned cvtpk(float lo, float hi) { return pk2(lo, hi); }
__device__ __forceinline__ bf16x8 frag_from(v2u lo, v2u hi) { v4u t = {lo.x, lo.y, hi.x, hi.y}; return __builtin_bit_cast(bf16x8, t); }

constexpr int DK_PITCH = 136, DV_PITCH = 264;
constexpr int DIL_VT_OFF = 256 * DK_PITCH * 2;
static_assert(DIL_VT_OFF + 128 * DV_PITCH * 2 <= 140000, "dil LDS");
__device__ __forceinline__ void dil_item2(int item, const bf16* PROJ, bf16* OPB, float* LSE, LAS unsigned char* lds, int tid) {
    const int tt = item & 31; int r3 = item >> 5; const int br = r3 % 3; r3 /= 3; const int h = r3 % DH, b = r3 / DH;
    const int d = br == 0 ? 1 : (br == 1 ? 4 : 16), tpr = 32 / d, res = tt / tpr, i0 = (tt % tpr) * 128, L = T / d;
    LAS bf16* Ks = (LAS bf16*)lds; LAS bf16* VTs = (LAS bf16*)(lds + DIL_VT_OFF);
    const bf16* base = PROJ + (size_t)b * T * NINP;
    const int lane = tid & 63, w = tid >> 6, ql = lane & 15, g = lane >> 4;
    const int tq = res + d * (i0 + 16 * w + ql);
    bf16x8 qf[4];
#pragma unroll
    for (int ks = 0; ks < 4; ++ks) qf[ks] = *(const GAS bf16x8*)(base + (size_t)tq * NINP + PC_DQ + h * DE + 32 * ks + 8 * g);
#pragma unroll 2
    for (int c = tid; c < 256 * 16; c += NTHR) { const int row = c >> 4, ch = c & 15, i = i0 - 64 + row;
        v4u kv = {0u, 0u, 0u, 0u}, vv = {0u, 0u, 0u, 0u};
        if (i >= 0 && i < L) { const bf16* rp = base + (size_t)(res + d * i) * NINP + h * DE + ch * 8; kv = *(const GAS v4u*)(rp + PC_DK); vv = *(const GAS v4u*)(rp + PC_DV); }
        *(LAS v4u*)(Ks + row * DK_PITCH + ch * 8) = kv;
        LAS bf16* vp = VTs + (ch * 8) * DV_PITCH + row;
        vp[0 * DV_PITCH] = (bf16)(vv.x & 0xffffu); vp[1 * DV_PITCH] = (bf16)(vv.x >> 16); vp[2 * DV_PITCH] = (bf16)(vv.y & 0xffffu); vp[3 * DV_PITCH] = (bf16)(vv.y >> 16);
        vp[4 * DV_PITCH] = (bf16)(vv.z & 0xffffu); vp[5 * DV_PITCH] = (bf16)(vv.z >> 16); vp[6 * DV_PITCH] = (bf16)(vv.w & 0xffffu); vp[7 * DV_PITCH] = (bf16)(vv.w >> 16); }
    __syncthreads();
    const float slope = exp2f(-8.0f * (float)(h + 1) / (float)DH) * (float)d, scale = 0.08838834764831845f;
    f32x4 st[9]; float mx = -1e30f;
#pragma unroll
    for (int kt = 0; kt < 9; ++kt) { f32x4 acc = {0.f, 0.f, 0.f, 0.f};
#pragma unroll
        for (int ks = 0; ks < 4; ++ks) { const bf16x8 a = *(const LAS bf16x8*)(Ks + (16 * w + 16 * kt + ql) * DK_PITCH + 32 * ks + 8 * g); acc = MFMA16(a, qf[ks], acc); }
#pragma unroll
        for (int e = 0; e < 4; ++e) { const int j = 16 * kt + 4 * g + e - 64 - ql, ik = i0 + 16 * w + ql + j; const int aj = j < 0 ? -j : j;
            const bool ok = (aj <= 64) && (ik >= 0) && (ik < L); const float s = ok ? acc[e] * scale - slope * (float)aj : -1e30f; acc[e] = s; mx = fmaxf(mx, s); }
        st[kt] = acc; }
    mx = fmaxf(mx, __shfl_xor(mx, 16)); mx = fmaxf(mx, __shfl_xor(mx, 32));
    float l = 0.f;
#pragma unroll
    for (int kt = 0; kt < 9; ++kt)
#pragma unroll
        for (int e = 0; e < 4; ++e) { const float p = __expf(st[kt][e] - mx); st[kt][e] = p; l += p; }
    l += __shfl_xor(l, 16); l += __shfl_xor(l, 32);
    bf16x8 pf[5];
#pragma unroll
    for (int t = 0; t < 4; ++t) { v4u u; u.x = cvtpk(st[2 * t][0], st[2 * t][1]); u.y = cvtpk(st[2 * t][2], st[2 * t][3]); u.z = cvtpk(st[2 * t + 1][0], st[2 * t + 1][1]); u.w = cvtpk(st[2 * t + 1][2], st[2 * t + 1][3]); pf[t] = __builtin_bit_cast(bf16x8, u); }
    { v4u u; u.x = cvtpk(st[8][0], st[8][1]); u.y = cvtpk(st[8][2], st[8][3]); u.z = 0u; u.w = 0u; pf[4] = __builtin_bit_cast(bf16x8, u); }
    const float inv = 1.f / l; const size_t tok = (size_t)b * T + tq;
    bf16* orow = OPB + ((size_t)br * M + tok) * DD + h * DE + 4 * g;
#pragma unroll
    for (int dt = 0; dt < 8; ++dt) { f32x4 o = {0.f, 0.f, 0.f, 0.f}; const LAS bf16* vrow = VTs + (16 * dt + ql) * DV_PITCH + 16 * w + 4 * g;
#pragma unroll
        for (int t = 0; t < 5; ++t) { const v2u lo = *(const LAS v2u*)(vrow + 32 * t), hi = *(const LAS v2u*)(vrow + 32 * t + (t < 4 ? 16 : 0)); o = MFMA16(frag_from(lo, hi), pf[t], o); }
        v2u wv; wv.x = cvtpk(o[0] * inv, o[1] * inv); wv.y = cvtpk(o[2] * inv, o[3] * inv); *(GAS v2u*)(orow + 16 * dt) = wv; }
    if (g == 0) LSE[((size_t)br * M + tok) * DH + h] = mx + __logf(l);
    __syncthreads();
}
__device__ __forceinline__ void dil_merge_item2(int item, const bf16* OPB, const float* LSE, bf16* CAT, int tid) {
    for (int e = tid; e < 32 * (DD / 4); e += NTHR) { const int tk = e / (DD / 4), c4 = e % (DD / 4), col = 4 * c4, h = col / DE; const size_t tok = (size_t)item * 32 + tk;
        const float l0 = LSE[((size_t)0 * M + tok) * DH + h], l1 = LSE[((size_t)1 * M + tok) * DH + h], l2 = LSE[((size_t)2 * M + tok) * DH + h];
        const float mm = fmaxf(l0, fmaxf(l1, l2)), w0 = __expf(l0 - mm), w1 = __expf(l1 - mm), w2 = __expf(l2 - mm), inv = 1.f / (w0 + w1 + w2);
        const v2u a = *(const GAS v2u*)(OPB + ((size_t)0 * M + tok) * DD + col), bq = *(const GAS v2u*)(OPB + ((size_t)1 * M + tok) * DD + col), c = *(const GAS v2u*)(OPB + ((size_t)2 * M + tok) * DD + col);
        const float o0 = (bflo(a.x) * w0 + bflo(bq.x) * w1 + bflo(c.x) * w2) * inv, o1 = (bfhi(a.x) * w0 + bfhi(bq.x) * w1 + bfhi(c.x) * w2) * inv;
        const float o2 = (bflo(a.y) * w0 + bflo(bq.y) * w1 + bflo(c.y) * w2) * inv, o3 = (bfhi(a.y) * w0 + bfhi(bq.y) * w1 + bfhi(c.y) * w2) * inv;
        v2u wv; wv.x = pk2(o0, o1); wv.y = pk2(o2, o3); *(GAS v2u*)(CAT + tok * D + GDV + col) = wv; }
}

constexpr int G_KT = 72, G_QP = 104;
__device__ __forceinline__ void vt_scatter(const bf16* PROJ, size_t tok0, int h, LAS bf16* VT, int tid) {
    for (int c = tid; c < 64 * 24; c += NTHR) { const int row = c / 24, ch = c % 24; const v4u a = *(const GAS v4u*)(PROJ + (tok0 + row) * NINP + PC_GV + h * GV + ch * 8); LAS bf16* vp = VT + (ch * 8) * G_KT + row;
        vp[0 * G_KT] = (bf16)(a.x & 0xffffu); vp[1 * G_KT] = (bf16)(a.x >> 16); vp[2 * G_KT] = (bf16)(a.y & 0xffffu); vp[3 * G_KT] = (bf16)(a.y >> 16);
        vp[4 * G_KT] = (bf16)(a.z & 0xffffu); vp[5 * G_KT] = (bf16)(a.z >> 16); vp[6 * G_KT] = (bf16)(a.w & 0xffffu); vp[7 * G_KT] = (bf16)(a.w >> 16); }
}
__device__ __forceinline__ void gla1_item2(int item, const bf16* PROJ, const float* wf, const float* bf_, const float* wb, const float* bb_, bf16* UT, float* LAF, float* LAB, float* DEC, LAS unsigned char* lds, int tid) {
    const int h = item & 3, n = (item >> 2) & 63, b = item >> 8; const size_t tok0 = (size_t)b * T + (size_t)n * GC;
    LAS float* cf = (LAS float*)lds; LAS float* cb = cf + 64 * 96; LAS float* rf = cb + 64 * 96; LAS float* rb = rf + 64 * 16;
    LAS bf16* KEF = (LAS bf16*)(lds + 57344); LAS bf16* KEB = KEF + 96 * G_KT; LAS bf16* VT = KEB + 96 * G_KT;
    for (int c = tid; c < 64 * 32; c += NTHR) { const int row = c >> 5, x = c & 31; const float v = bf2f(PROJ[(tok0 + row) * NINP + PC_RF + x]); if (x < 16) rf[row * 16 + x] = v; else rb[row * 16 + x - 16] = v; }
    vt_scatter(PROJ, tok0, h, VT, tid);
    __syncthreads();
    for (int idx = tid; idx < 64 * 96; idx += NTHR) { const int c = idx / 96, k = idx % 96, hk = h * GK + k; float zf = bf_[hk], zb = bb_[hk];
#pragma unroll
        for (int r = 0; r < 16; ++r) { zf += rf[c * 16 + r] * wf[r * GDK + hk]; zb += rb[c * 16 + r] * wb[r * GDK + hk]; }
        cf[idx] = (fminf(zf, 0.f) - __logf(1.f + __expf(-fabsf(zf)))) * (1.f / 16.f); cb[idx] = (fminf(zb, 0.f) - __logf(1.f + __expf(-fabsf(zb)))) * (1.f / 16.f); }
    __syncthreads();
    if (tid < 96) { float run = 0.f;
#pragma unroll 4
        for (int c = 0; c < 64; ++c) { run += cf[c * 96 + tid]; cf[c * 96 + tid] = run; } }
    else if (tid < 192) { const int k = tid - 96; float run = 0.f;
#pragma unroll 4
        for (int c = 63; c >= 0; --c) { run += cb[c * 96 + k]; cb[c * 96 + k] = run; } }
    __syncthreads();
    const size_t cid = ((size_t)(b * NCH + n) * GH + h) * 2;
    if (tid < 96) DEC[(cid + 0) * GK + tid] = __expf(cf[63 * 96 + tid]); else if (tid < 192) DEC[(cid + 1) * GK + tid - 96] = __expf(cb[tid - 96]);
    for (int idx = tid; idx < 64 * 96; idx += NTHR) { const int s = idx / 96, k = idx % 96; const float f = cf[idx], bk = cb[idx];
        LAF[(tok0 + s) * GDK + h * GK + k] = f; LAB[(tok0 + s) * GDK + h * GK + k] = bk;
        const float kv = bf2f(PROJ[(tok0 + s) * NINP + PC_GK + h * GK + k]);
        KEF[k * G_KT + s] = (bf16)f2bf(kv * __expf(cf[63 * 96 + k] - f)); KEB[k * G_KT + s] = (bf16)f2bf(kv * __expf(cb[k] - bk)); }
    __syncthreads();
    const int lane = tid & 63, w = tid >> 6, ql = lane & 15, g = lane >> 4;
#pragma unroll 1
    for (int ti = 0; ti < 9; ++ti) { const int idx = 9 * w + ti, kt = idx / 12, vt = idx % 12;
        const bf16x8 v0 = *(const LAS bf16x8*)(VT + (16 * vt + ql) * G_KT + 8 * g), v1 = *(const LAS bf16x8*)(VT + (16 * vt + ql) * G_KT + 32 + 8 * g);
#pragma unroll
        for (int dir = 0; dir < 2; ++dir) { const LAS bf16* KE = dir ? KEB : KEF; f32x4 acc = {0.f, 0.f, 0.f, 0.f};
            acc = MFMA16(*(const LAS bf16x8*)(KE + (16 * kt + ql) * G_KT + 8 * g), v0, acc); acc = MFMA16(*(const LAS bf16x8*)(KE + (16 * kt + ql) * G_KT + 32 + 8 * g), v1, acc);
            v2u wv; wv.x = cvtpk(acc[0], acc[1]); wv.y = cvtpk(acc[2], acc[3]);
            *(GAS v2u*)(UT + (cid + dir) * (GK * GV) + (size_t)(16 * vt + ql) * GK + 16 * kt + 4 * g) = wv; } }
    __syncthreads();
}
__device__ __forceinline__ void gla2_phase2(bf16* UT, const float* DEC, int bid, int G, int tid) {
    GAS unsigned* U32 = (GAS unsigned*)UT; constexpr int NP = GK * GV / 2;
    for (int pi = bid * NTHR + tid; pi < BATCH * GH * 2 * NP; pi += G * NTHR) {
        const int kv2 = pi % NP; int r = pi / NP; const int dir = r & 1; r >>= 1; const int h = r % GH, b = r / GH, k0 = (kv2 % (GK / 2)) * 2; float S0 = 0.f, S1 = 0.f;
#pragma unroll 1
        for (int st0 = 0; st0 < NCH; st0 += 8) { unsigned wv[8]; float d0[8], d1[8];
#pragma unroll
            for (int q = 0; q < 8; ++q) { const int n = dir ? NCH - 1 - (st0 + q) : st0 + q; const size_t cid = ((size_t)(b * NCH + n) * GH + h) * 2 + dir; wv[q] = U32[cid * NP + kv2]; d0[q] = DEC[cid * GK + k0]; d1[q] = DEC[cid * GK + k0 + 1]; }
#pragma unroll
            for (int q = 0; q < 8; ++q) { const int n = dir ? NCH - 1 - (st0 + q) : st0 + q; const size_t cid = ((size_t)(b * NCH + n) * GH + h) * 2 + dir; U32[cid * NP + kv2] = cvtpk(S0, S1); S0 = d0[q] * S0 + bflo(wv[q]); S1 = d1[q] * S1 + bfhi(wv[q]); } }
    }
}
__device__ __forceinline__ void gla3_item2(int item, const bf16* PROJ, const bf16* UT, const float* LAF, const float* LAB, const float* gn, bf16* CAT, LAS unsigned char* lds, int tid) {
    const int h = item & 3, n = (item >> 2) & 63, b = item >> 8; const size_t tok0 = (size_t)b * T + (size_t)n * GC;
    LAS bf16* QD = (LAS bf16*)lds; LAS bf16* KI = QD + 64 * G_QP; LAS bf16* VT = KI + 64 * G_QP; LAS bf16* ST = VT + 192 * G_KT; LAS float* SS = (LAS float*)(ST + 192 * G_QP);
    const int lane = tid & 63, w = tid >> 6, ql = lane & 15, g = lane >> 4, ct = w & 3, vh = w >> 2;
    vt_scatter(PROJ, tok0, h, VT, tid);
    f32x4 acc_o[6];
#pragma unroll
    for (int vt = 0; vt < 6; ++vt) acc_o[vt] = (f32x4){0.f, 0.f, 0.f, 0.f};
    const size_t cid = ((size_t)(b * NCH + n) * GH + h) * 2;
#pragma unroll 1
    for (int dir = 0; dir < 2; ++dir) {
        const float* LA = dir ? LAB : LAF;
        for (int idx = tid; idx < 64 * 96; idx += NTHR) { const int c = idx / 96, k = idx % 96; const float bc = LA[(tok0 + c) * GDK + h * GK + k];
            const float qv = bf2f(PROJ[(tok0 + c) * NINP + PC_GQ + h * GK + k]), kv = bf2f(PROJ[(tok0 + c) * NINP + PC_GK + h * GK + k]);
            QD[c * G_QP + k] = (bf16)f2bf(qv * 0.10206207261596577f * __expf(bc)); KI[c * G_QP + k] = (bf16)f2bf(kv * __expf(-bc)); }
        for (int c2 = tid; c2 < 192 * 12; c2 += NTHR) { const int row = c2 / 12, ch = c2 % 12; *(LAS v4u*)(ST + row * G_QP + ch * 8) = *(const GAS v4u*)(UT + (cid + dir) * (GK * GV) + (size_t)row * GK + ch * 8); }
        __syncthreads();
        bf16x8 qf[3];
#pragma unroll
        for (int ks = 0; ks < 3; ++ks) qf[ks] = *(const LAS bf16x8*)(QD + (16 * ct + ql) * G_QP + 32 * ks + 8 * g);
        f32x4 at[4];
#pragma unroll
        for (int s4 = 0; s4 < 4; ++s4) { f32x4 a = {0.f, 0.f, 0.f, 0.f};
#pragma unroll
            for (int ks = 0; ks < 3; ++ks) a = MFMA16(*(const LAS bf16x8*)(KI + (16 * s4 + ql) * G_QP + 32 * ks + 8 * g), qf[ks], a);
#pragma unroll
            for (int e = 0; e < 4; ++e) { const int s = 16 * s4 + 4 * g + e, c = 16 * ct + ql; const bool keep = dir ? (s >= c) : (s <= c); a[e] = keep ? a[e] : 0.f; }
            at[s4] = a; }
        bf16x8 pf[2];
#pragma unroll
        for (int t = 0; t < 2; ++t) { v4u u; u.x = cvtpk(at[2 * t][0], at[2 * t][1]); u.y = cvtpk(at[2 * t][2], at[2 * t][3]); u.z = cvtpk(at[2 * t + 1][0], at[2 * t + 1][1]); u.w = cvtpk(at[2 * t + 1][2], at[2 * t + 1][3]); pf[t] = __builtin_bit_cast(bf16x8, u); }
#pragma unroll
        for (int vt = 0; vt < 6; ++vt) { const int vrow = 96 * vh + 16 * vt + ql; f32x4 o = acc_o[vt];
#pragma unroll
            for (int t = 0; t < 2; ++t) { const v2u lo = *(const LAS v2u*)(VT + vrow * G_KT + 32 * t + 4 * g), hi = *(const LAS v2u*)(VT + vrow * G_KT + 32 * t + 16 + 4 * g); o = MFMA16(frag_from(lo, hi), pf[t], o); }
#pragma unroll
            for (int ks = 0; ks < 3; ++ks) o = MFMA16(*(const LAS bf16x8*)(ST + vrow * G_QP + 32 * ks + 8 * g), qf[ks], o);
            acc_o[vt] = o; }
        __syncthreads();
    }
    float ss = 0.f;
#pragma unroll
    for (int vt = 0; vt < 6; ++vt) ss += (acc_o[vt][0] * acc_o[vt][0] + acc_o[vt][1] * acc_o[vt][1]) + (acc_o[vt][2] * acc_o[vt][2] + acc_o[vt][3] * acc_o[vt][3]);
    ss += __shfl_xor(ss, 16); ss += __shfl_xor(ss, 32);
    if (g == 0) SS[vh * 64 + 16 * ct + ql] = ss;
    __syncthreads();
    const float r = 1.f / sqrtf((SS[16 * ct + ql] + SS[64 + 16 * ct + ql]) * (1.f / GV) + LN_EPS);
    const size_t tok = tok0 + 16 * ct + ql;
#pragma unroll
    for (int vt = 0; vt < 6; ++vt) { const int v0 = h * GV + 96 * vh + 16 * vt + 4 * g; const v2u gq = *(const GAS v2u*)(PROJ + tok * NINP + PC_GG + v0); const f32x4 gnv = *(const GAS f32x4*)(gn + v0);
        const float g0 = bflo(gq.x), g1 = bfhi(gq.x), g2 = bflo(gq.y), g3 = bfhi(gq.y);
        const float o0 = acc_o[vt][0] * r * gnv.x * (g0 / (1.f + __expf(-g0))), o1 = acc_o[vt][1] * r * gnv.y * (g1 / (1.f + __expf(-g1)));
        const float o2 = acc_o[vt][2] * r * gnv.z * (g2 / (1.f + __expf(-g2))), o3 = acc_o[vt][3] * r * gnv.w * (g3 / (1.f + __expf(-g3)));
        v2u wv; wv.x = cvtpk(o0, o1); wv.y = cvtpk(o2, o3); *(GAS v2u*)(CAT + tok * D + v0) = wv; }
    __syncthreads();
}
typedef __attribute__((address_space(4))) const unsigned long long kargq;
__device__ __forceinline__ kargq* karg_base() { kargq* kp = (kargq*)__builtin_amdgcn_kernarg_segment_ptr(); asm volatile("" : "+s"(kp)); return kp; }
__device__ __forceinline__ const float* karg_in(int i) { return (const float*)karg_base()[i]; }
__device__ __forceinline__ float* karg_out() { return (float*)karg_base()[24]; }
__device__ __forceinline__ unsigned char* karg_ws() { return (unsigned char*)karg_base()[25]; }
struct Args { const float* in[24]; float* out; unsigned char* ws; };
#ifndef STOP_AFTER
#define STOP_AFTER 1000000
#endif
__global__ void __launch_bounds__(NTHR, 2) fwd_kernel(Args a) {
    extern __shared__ __attribute__((aligned(16))) unsigned char lds_raw[];
    LAS unsigned char* lds = (LAS unsigned char*)lds_raw;
    volatile LAS unsigned* MISC = (volatile LAS unsigned*)(lds + MISC_OFF);
    const int tid0 = threadIdx.x;
#define IDS() int tid = threadIdx.x; asm volatile("" : "+v"(tid)); const int lane = tid & 63, wave = __builtin_amdgcn_readfirstlane(tid >> 6); int G = gridDim.x, bid = blockIdx.x; asm volatile("" : "+s"(G), "+s"(bid)); (void)lane; (void)wave
    if (tid0 < 32) MISC[tid0] = 0u;
    __syncthreads();
    XcdBarrier bar = xcd_barrier_post((unsigned*)(karg_ws() + WS_CTL) + CW_BAR, MISC + 8);
    int phase_no = 0;
#define GRID_BAR() do { XcdBarrier b2_ = bar; asm volatile("" : "+s"(b2_.bar)); xcd_barrier(b2_); if (++phase_no > STOP_AFTER) return; } while (0)

#define XF ((float*)(karg_ws() + WS_XF))
#define Z ((float*)(karg_ws() + WS_Z))
#define XB ((bf16*)(karg_ws() + WS_XB))
#define CAT ((bf16*)(karg_ws() + WS_CAT))
#define HB ((bf16*)(karg_ws() + WS_HP))
#define PROJ ((bf16*)(karg_ws() + WS_HP))
#define UT ((bf16*)(karg_ws() + WS_U))
#define LAF ((float*)(karg_ws() + WS_LAF))
#define LAB ((float*)(karg_ws() + WS_LAB))
#define DEC ((float*)(karg_ws() + WS_DEC))
#define OPB ((bf16*)(karg_ws() + WS_OP))
#define LSE ((float*)(karg_ws() + WS_LSE))
#define wsw (karg_ws() + WS_W)
#define WGU1 ((bf16*)(wsw + WO_GU1))
#define WD1 ((bf16*)(wsw + WO_D1))
#define WIN ((bf16*)(wsw + WO_IN))
#define WOUT ((bf16*)(wsw + WO_OUT))
#define WGU2 ((bf16*)(wsw + WO_GU2))
#define WD2 ((bf16*)(wsw + WO_D2))
    for (int l = 0; l < DEPTH; ++l) {
        { IDS(); LayerW w; const size_t so = (size_t)l * D * FF;
          w.g1 = karg_in(1) + so; w.u1 = karg_in(2) + so; w.d1 = karg_in(3) + so; w.win = karg_in(6) + (size_t)l * D * NIN; w.wout = karg_in(16) + (size_t)l * D * D;
          w.g2 = karg_in(19) + so; w.u2 = karg_in(20) + so; w.d2 = karg_in(21) + so;
          convert_phase(w, wsw, lds, bid, G, wave, lane, tid);
          if (l == 0) cast_phase(karg_in(0), XB, bid, G, tid); }
        GRID_BAR();
        { IDS(); pg8::Gemm g{XB, WGU1, M, NGU, D}; pg8::StaticOrder S; S.init(M, NGU, G, bid); pg8::EpiSwiglu E{HB, FF};
          pg8::gemm_phase<pg8::EpiSwiglu, pg8::StaticOrder, true, true>(lds, g, S, E); }
        GRID_BAR();
        { IDS(); pg8::Gemm g{HB, WD1, M, D, FF}; pg8::StaticOrder S; S.init(M, D, G, bid); pg8::EpiResid E{l == 0 ? karg_in(0) : XF, Z, D, DN_ALPHA, 0.5f};
          pg8::gemm_phase<pg8::EpiResid, pg8::StaticOrder, true, true>(lds, g, S, E); }
        GRID_BAR();
        { IDS(); ln_phase(Z, karg_in(4) + (size_t)l * D, karg_in(5) + (size_t)l * D, XF, XB, bid, G, wave, lane); }
        GRID_BAR();
        { IDS(); pg8::Gemm g{XB, WIN, M, NINP, D}; pg8::StaticOrder S; S.init(M, NINP, G, bid); pg8::EpiBf16 E{PROJ, NINP};
          pg8::gemm_phase<pg8::EpiBf16, pg8::StaticOrder, true, true>(lds, g, S, E); }
        GRID_BAR();
        { IDS(); constexpr int N_DIL = BATCH * DH * 3 * 32, N_G1 = BATCH * NCH * GH, N_CV = BATCH * (T / 32);
          for (int it = bid; it < N_DIL + N_G1 + N_CV; it += G) {
              if (it < N_DIL) dil_item2(it, PROJ, OPB, LSE, lds, tid);
              else if (it < N_DIL + N_G1) gla1_item2(it - N_DIL, PROJ, karg_in(7) + (size_t)l * GR * GDK, karg_in(8) + (size_t)l * GDK, karg_in(9) + (size_t)l * GR * GDK, karg_in(10) + (size_t)l * GDK, UT, LAF, LAB, DEC, lds, tid);
              else conv_item(it - N_DIL - N_G1, PROJ, karg_in(12) + (size_t)l * CK * CC, karg_in(13) + (size_t)l * CC, karg_in(14) + (size_t)l * CC, karg_in(15) + (size_t)l * CC, CAT, lds, tid, wave, lane);
          } }
        GRID_BAR();
        { IDS(); gla2_phase2(UT, DEC, bid, G, tid); }
        GRID_BAR();
        { IDS(); constexpr int N_G3 = BATCH * NCH * GH, N_MG = M / 32;
          for (int it = bid; it < N_G3 + N_MG; it += G) {
              if (it < N_G3) gla3_item2(it, PROJ, UT, LAF, LAB, karg_in(11) + (size_t)l * GDV, CAT, lds, tid);
              else dil_merge_item2(it - N_G3, OPB, LSE, CAT, tid);
          } }
        GRID_BAR();
        { IDS(); pg8::Gemm g{CAT, WOUT, M, D, D}; pg8::StaticOrder S; S.init(M, D, G, bid); pg8::EpiResid E{XF, Z, D, DN_ALPHA, 1.0f};
          pg8::gemm_phase<pg8::EpiResid, pg8::StaticOrder, true, true>(lds, g, S, E); }
        GRID_BAR();
        { IDS(); ln_phase(Z, karg_in(17) + (size_t)l * D, karg_in(18) + (size_t)l * D, XF, XB, bid, G, wave, lane); }
        GRID_BAR();
        { IDS(); pg8::Gemm g{XB, WGU2, M, NGU, D}; pg8::StaticOrder S; S.init(M, NGU, G, bid); pg8::EpiSwiglu E{HB, FF};
          pg8::gemm_phase<pg8::EpiSwiglu, pg8::StaticOrder, true, true>(lds, g, S, E); }
        GRID_BAR();
        { IDS(); pg8::Gemm g{HB, WD2, M, D, FF}; pg8::StaticOrder S; S.init(M, D, G, bid); pg8::EpiResid E{XF, Z, D, DN_ALPHA, 0.5f};
          pg8::gemm_phase<pg8::EpiResid, pg8::StaticOrder, true, true>(lds, g, S, E); }
        GRID_BAR();
        { IDS(); ln_phase(Z, karg_in(22) + (size_t)l * D, karg_in(23) + (size_t)l * D, l == DEPTH - 1 ? karg_out() : XF, XB, bid, G, wave, lane); }
        GRID_BAR();
    }
}

extern "C" void kernel_launch(void* const* d_in, const int* in_sizes, int n_in, void* d_out, int out_size, void* d_ws, size_t ws_size, hipStream_t stream) {
    static int grid = 0;
    if (grid == 0) {
        if (n_in != 24 || in_sizes[0] != M * D || out_size != M * D || ws_size < WS_END) { fprintf(stderr, "kernel_launch: unexpected problem shape / workspace (n_in %d, ws %zu < %zu); nothing launched\n", n_in, ws_size, (size_t)WS_END); grid = -1; return; }
        int dev = 0, cus = 0, per_cu = 0;
        if (hipGetDevice(&dev) != hipSuccess || hipDeviceGetAttribute(&cus, hipDeviceAttributeMultiprocessorCount, dev) != hipSuccess) { grid = -1; return; }
        if (hipFuncSetAttribute((const void*)fwd_kernel, hipFuncAttributeMaxDynamicSharedMemorySize, LDS_BYTES) != hipSuccess) { fprintf(stderr, "kernel_launch: hipFuncSetAttribute failed\n"); grid = -1; return; }
        if (hipOccupancyMaxActiveBlocksPerMultiprocessor(&per_cu, (const void*)fwd_kernel, NTHR, LDS_BYTES) != hipSuccess || per_cu < 1) fprintf(stderr, "kernel_launch: occupancy query reports %d\n", per_cu);
        (void)hipGetLastError();
        grid = cus;
    }
    if (grid < 0) return;
    if (hipMemsetAsync((char*)d_ws + WS_CTL, 0, CTL_ZERO_BYTES, stream) != hipSuccess) return;
    Args a{};
    for (int i = 0; i < 24; ++i) a.in[i] = (const float*)d_in[i];
    a.out = (float*)d_out; a.ws = (unsigned char*)d_ws;
    hipLaunchKernelGGL(fwd_kernel, dim3(grid), dim3(NTHR), LDS_BYTES, stream, a);
}
```

```cpp
#include <hip/hip_runtime.h>
#include <cstdio>
#include <cstdint>
namespace pg8 {
#define PG8_LAS __attribute__((address_space(3)))
typedef unsigned short bf16_t;
typedef short bf16x8 __attribute__((ext_vector_type(8)));
typedef float f32x4 __attribute__((ext_vector_type(4)));
typedef unsigned u32x4 __attribute__((ext_vector_type(4)));
constexpr int BM = 256, BK = 64, HALF = 128, HTB = HALF * BK * 2  , STAGE_BYTES = 8 * HTB, NXCD = 8, WGM = 8;

__host__ __device__ __forceinline__ int lds_byte(int r, int c) { const int st = (r >> 4) * 2 + (c >> 5), rr = r & 15, cc = c & 31, ob = rr * 64 + cc * 2; return st * 1024 + (ob ^ (((ob >> 9) & 1) << 5)); }
__host__ __device__ __forceinline__ void stage_rc(int b, int& R, int& C) { const int st = b / 1024, sb = b % 1024, swz = sb ^ (((sb >> 9) & 1) << 5); R = (st >> 1) * 16 + swz / 64; C = (st & 1) * 32 + (swz % 64) / 2; }
__host__ __device__ __forceinline__ int perm32(int rho) { const int n = rho >> 4, i = rho & 15; return 8 * (i >> 2) + 4 * n + (i & 3); }

struct Unit { int pm, pn; };
struct Gemm { const bf16_t* A; const bf16_t* Bt; int M, N, K; };

struct StaticOrder {
    int nM, nN, nwg, G, c;
    __host__ __device__ void init(int M, int N, int G_, int c_) { nM = M / BM; nN = N / BM; nwg = nM * nN; G = G_; c = c_; }
    __host__ __device__ bool next(int i, Unit& u) const {
        const long L = (long)i * G + c; if (L >= nwg) return false;
        int wgid = (int)L; { const int q = nwg / NXCD, r = nwg % NXCD, xcd = wgid % NXCD, off = wgid / NXCD; wgid = (xcd < r ? xcd * (q + 1) : r * (q + 1) + (xcd - r) * q) + off; }
        const int nig = WGM * nN, gid = wgid / nig, fm = gid * WGM, gsz = (nM - fm) < WGM ? (nM - fm) : WGM;
        u.pm = fm + ((wgid % nig) % gsz); u.pn = (wgid % nig) / gsz; return true;
    }
    __device__ __forceinline__ void a_ready(const Unit&) const {}
    __device__ __forceinline__ void done(const Unit&) const {}
};

template <class Epi, class Sched, bool ALIGN_EPI = false, bool SP2 = false>
__device__ __forceinline__ void gemm_phase(PG8_LAS unsigned char* lds, const Gemm g, const Sched& S, const Epi& E) {
    int tid_l = threadIdx.x; asm volatile("" : "+v"(tid_l));
    const int tid = tid_l, wid = __builtin_amdgcn_readfirstlane(tid >> 6), lane = tid & 63, wr = wid >> 2, wc = wid & 3, fr = lane & 15, fq = lane >> 4;
    const int K = g.K, nt = K / BK;
    unsigned voffA[2], voffB[2];
#pragma unroll
    for (int i = 0; i < 2; ++i) { int R, C; stage_rc(tid * 16 + i * 8192, R, C); const int Rb = Epi::PERM ? ((R & ~31) + perm32(R & 31)) : R;
        voffA[i] = (unsigned)(R * K + C) * 2u; voffB[i] = (unsigned)(Rb * K + C) * 2u; }
    const size_t kstep = (size_t)(BK * 2);
    const size_t hstep = (size_t)HALF * K * 2;
    const size_t tstep = 2 * hstep;
    const unsigned ldsw = (unsigned)wid * 1024u;
    const int aoff = lds_byte(wr * 64 + fr, fq * 8), boff = lds_byte(wc * 32 + fr, fq * 8);
#define PG8_SA(b, h) (((b) * 2 + (h)) * HTB)
#define PG8_SB(b, h) ((4 + (b) * 2 + (h)) * HTB)
#define PG8_STAGE(bufoff, gbase, voff) do { _Pragma("unroll") for (int _i = 0; _i < 2; ++_i) \
        __builtin_amdgcn_global_load_lds((const unsigned*)((const char*)(gbase) + (voff)[_i]), (PG8_LAS unsigned*)(lds + (bufoff) + ldsw + _i * 8192), 16, 0, 0); } while (0)
#define PG8_LDA(dst, b, h) do { _Pragma("unroll") for (int m = 0; m < 4; ++m) _Pragma("unroll") for (int k = 0; k < 2; ++k) dst[m][k] = *(const PG8_LAS bf16x8*)(lds + PG8_SA(b, h) + aoff + m * 2048 + k * 1024); } while (0)
#define PG8_LDB(dst, b, h) do { _Pragma("unroll") for (int n = 0; n < 2; ++n) _Pragma("unroll") for (int k = 0; k < 2; ++k) dst[n][k] = *(const PG8_LAS bf16x8*)(lds + PG8_SB(b, h) + boff + n * 2048 + k * 1024); } while (0)
#define PG8_MMA(ai, bj, At, Bt) do { __builtin_amdgcn_s_setprio(1); _Pragma("unroll") for (int m = 0; m < 4; ++m) _Pragma("unroll") for (int n = 0; n < 2; ++n) _Pragma("unroll") for (int k = 0; k < 2; ++k) \
        acc[ai][bj][m][n] = __builtin_amdgcn_mfma_f32_16x16x32_bf16(Bt[n][k], At[m][k], acc[ai][bj][m][n], 0, 0, 0); __builtin_amdgcn_s_setprio(0); } while (0)
#define PG8_WAIT_V(n) asm volatile("s_waitcnt vmcnt(" #n ")" ::: "memory")
#define PG8_WAIT_L(n) asm volatile("s_waitcnt lgkmcnt(" #n ")" ::: "memory")
#define PG8_BAR __builtin_amdgcn_s_barrier()
#define PG8_SCHED __builtin_amdgcn_sched_barrier(0)
    Unit cur, nxt; int ui = 0;
    if (!S.next(0, cur)) return;
    f32x4 acc[2][2][4][2];
#pragma unroll
    for (int a = 0; a < 2; ++a)
#pragma unroll
        for (int b = 0; b < 2; ++b)
#pragma unroll
            for (int m = 0; m < 4; ++m)
#pragma unroll
                for (int n = 0; n < 2; ++n) acc[a][b][m][n] = (f32x4){0.f, 0.f, 0.f, 0.f};
    bf16x8 At[4][2], B0[2][2], B1[2][2];
    const char* cA = (const char*)g.A + (size_t)cur.pm * tstep; const char* cB = (const char*)g.Bt + (size_t)cur.pn * tstep;
    S.a_ready(cur);
    if constexpr (SP2) {
        PG8_STAGE(PG8_SB(0, 0), cB, voffB); PG8_STAGE(PG8_SB(0, 1), cB + hstep, voffB); PG8_STAGE(PG8_SA(0, 0), cA, voffA); PG8_STAGE(PG8_SA(0, 1), cA + hstep, voffA);
        if (wr == 1) PG8_BAR;
        PG8_WAIT_V(2); PG8_BAR;
        PG8_STAGE(PG8_SB(1, 0), cB + kstep, voffB); PG8_STAGE(PG8_SA(1, 0), cA + kstep, voffA); PG8_STAGE(PG8_SB(1, 1), cB + hstep + kstep, voffB);
        PG8_WAIT_V(6); PG8_BAR;
    } else {
        PG8_STAGE(PG8_SB(0, 0), cB, voffB); PG8_STAGE(PG8_SA(0, 0), cA, voffA); PG8_STAGE(PG8_SB(0, 1), cB + hstep, voffB); PG8_STAGE(PG8_SA(0, 1), cA + hstep, voffA);
        if (wr == 1) PG8_BAR;
        PG8_WAIT_V(4); PG8_BAR;
        PG8_STAGE(PG8_SB(1, 0), cB + kstep, voffB); PG8_STAGE(PG8_SA(1, 0), cA + kstep, voffA); PG8_STAGE(PG8_SB(1, 1), cB + hstep + kstep, voffB);
        PG8_WAIT_V(6); PG8_BAR;
    }
    for (;;) {
        const bool has_next = S.next(ui + 1, nxt);
        const char* nA = has_next ? (const char*)g.A + (size_t)nxt.pm * tstep : cA; const char* nB = has_next ? (const char*)g.Bt + (size_t)nxt.pn * tstep : cB;
        for (int t = 0; t < nt; t += 2) {
            const bool last = (t == nt - 2);
            const char* a1 = cA + (size_t)(t + 1) * kstep;
            const char* a2 = last ? nA : cA + (size_t)(t + 2) * kstep; const char* b2 = last ? nB : cB + (size_t)(t + 2) * kstep;
            const char* a3 = a2 + kstep; const char* b3 = b2 + kstep;
            if (last && has_next) S.a_ready(nxt);
            if constexpr (SP2) {
            PG8_LDB(B0, 0, 0); PG8_LDB(B1, 0, 1); PG8_SCHED; PG8_LDA(At, 0, 0); PG8_STAGE(PG8_SA(1, 1), a1 + hstep, voffA);
            PG8_WAIT_V(8); PG8_WAIT_L(0); PG8_BAR; PG8_MMA(0, 0, At, B0); PG8_MMA(0, 1, At, B1); PG8_BAR; PG8_SCHED;
            PG8_LDA(At, 0, 1); PG8_STAGE(PG8_SB(0, 0), b2, voffB); PG8_STAGE(PG8_SB(0, 1), b2 + hstep, voffB); PG8_STAGE(PG8_SA(0, 0), a2, voffA);
            PG8_WAIT_V(8); PG8_WAIT_L(0); PG8_BAR; PG8_MMA(1, 0, At, B0); PG8_MMA(1, 1, At, B1); PG8_BAR; PG8_SCHED;
            PG8_LDB(B0, 1, 0); PG8_LDB(B1, 1, 1); PG8_SCHED; PG8_LDA(At, 1, 0); PG8_STAGE(PG8_SA(0, 1), a2 + hstep, voffA);
            PG8_WAIT_V(8); PG8_WAIT_L(0); PG8_BAR; PG8_MMA(0, 0, At, B0); PG8_MMA(0, 1, At, B1); PG8_BAR; PG8_SCHED;
            PG8_LDA(At, 1, 1); PG8_STAGE(PG8_SB(1, 0), b3, voffB); PG8_STAGE(PG8_SB(1, 1), b3 + hstep, voffB); PG8_STAGE(PG8_SA(1, 0), a3, voffA);
            PG8_WAIT_V(8); PG8_WAIT_L(0); PG8_BAR; PG8_MMA(1, 0, At, B0); PG8_MMA(1, 1, At, B1); PG8_BAR; PG8_SCHED;
            } else {
            PG8_LDB(B0, 0, 0); PG8_SCHED; PG8_LDA(At, 0, 0); PG8_STAGE(PG8_SA(1, 1), a1 + hstep, voffA);
            PG8_WAIT_L(8); PG8_BAR; PG8_WAIT_L(0); PG8_MMA(0, 0, At, B0); PG8_BAR; PG8_SCHED;
            PG8_LDB(B1, 0, 1); PG8_STAGE(PG8_SB(0, 0), b2, voffB);
            PG8_BAR; PG8_WAIT_L(0); PG8_MMA(0, 1, At, B1); PG8_BAR;
            PG8_LDA(At, 0, 1); PG8_STAGE(PG8_SA(0, 0), a2, voffA);
            PG8_BAR; PG8_WAIT_L(0); PG8_MMA(1, 0, At, B0); PG8_BAR; PG8_SCHED;
            PG8_STAGE(PG8_SB(0, 1), b2 + hstep, voffB);
            PG8_WAIT_V(6); PG8_BAR; PG8_MMA(1, 1, At, B1); PG8_BAR;
            PG8_LDB(B0, 1, 0); PG8_SCHED; PG8_LDA(At, 1, 0); PG8_STAGE(PG8_SA(0, 1), a2 + hstep, voffA);
            PG8_WAIT_L(8); PG8_BAR; PG8_WAIT_L(0); PG8_MMA(0, 0, At, B0); PG8_BAR; PG8_SCHED;
            PG8_LDB(B1, 1, 1); PG8_STAGE(PG8_SB(1, 0), b3, voffB);
            PG8_BAR; PG8_WAIT_L(0); PG8_MMA(0, 1, At, B1); PG8_BAR;
            PG8_LDA(At, 1, 1); PG8_STAGE(PG8_SA(1, 0), a3, voffA);
            PG8_BAR; PG8_WAIT_L(0); PG8_MMA(1, 0, At, B0); PG8_BAR; PG8_SCHED;
            PG8_STAGE(PG8_SB(1, 1), b3 + hstep, voffB);
            PG8_WAIT_V(6); PG8_BAR; PG8_MMA(1, 1, At, B1); PG8_BAR;
            }
        }
        if constexpr (ALIGN_EPI) { if (wr == 0) PG8_BAR; }
        if constexpr (!Epi::AFTER_DRAIN) { E(acc, cur, wr, wc, fr, fq); S.done(cur); }
        if (!has_next) break;
#pragma unroll
        for (int a = 0; a < 2; ++a)
#pragma unroll
            for (int b = 0; b < 2; ++b)
#pragma unroll
                for (int m = 0; m < 4; ++m)
#pragma unroll
                    for (int n = 0; n < 2; ++n) acc[a][b][m][n] = (f32x4){0.f, 0.f, 0.f, 0.f};
        cur = nxt; cA = nA; cB = nB; ++ui;
        if constexpr (ALIGN_EPI) { if (wr == 1) PG8_BAR; }
    }
    PG8_WAIT_V(0);
    if constexpr (!ALIGN_EPI) { if (wr == 0) PG8_BAR; }
    PG8_BAR;
    if constexpr (Epi::AFTER_DRAIN) { E.fused(acc, cur, wr, wc, fr, fq, lds, wid, lane); S.done(cur); }
#undef PG8_SA
#undef PG8_SB
#undef PG8_STAGE
#undef PG8_LDA
#undef PG8_LDB
#undef PG8_MMA
#undef PG8_WAIT_V
#undef PG8_WAIT_L
#undef PG8_BAR
#undef PG8_SCHED
}
}
namespace pg8 {
typedef float f32x2c __attribute__((ext_vector_type(2))); typedef __bf16 bf16x2c __attribute__((ext_vector_type(2)));
__device__ __forceinline__ unsigned cvt_pk_bf16(float lo, float hi) { f32x2c v = {lo, hi}; return __builtin_bit_cast(unsigned, __builtin_convertvector(v, bf16x2c)); }
struct EpiBf16 {
    static constexpr bool PERM = true, AFTER_DRAIN = false;
    bf16_t* O; int ldc;
    __device__ __forceinline__ void operator()(const f32x4 (&acc)[2][2][4][2], const Unit& u, int wr, int wc, int fr, int fq) const {
        const int row0 = u.pm * BM + wr * 64 + fr; const int col0 = u.pn * BM + wc * 32 + 8 * fq;
#pragma unroll
        for (int ai = 0; ai < 2; ++ai)
#pragma unroll
            for (int m = 0; m < 4; ++m) { bf16_t* rowp = O + (size_t)(row0 + ai * HALF + m * 16) * ldc + col0;
#pragma unroll
                for (int bj = 0; bj < 2; ++bj) { const f32x4 v0 = acc[ai][bj][m][0], v1 = acc[ai][bj][m][1];
                    u32x4 w; w.x = cvt_pk_bf16(v0[0], v0[1]); w.y = cvt_pk_bf16(v0[2], v0[3]); w.z = cvt_pk_bf16(v1[0], v1[1]); w.w = cvt_pk_bf16(v1[2], v1[3]);
                    *(u32x4*)(rowp + bj * HALF) = w; } }
    }
};
struct EpiSwiglu {
    static constexpr bool PERM = true, AFTER_DRAIN = false;
    bf16_t* O; int ldc;
    __device__ __forceinline__ void operator()(const f32x4 (&acc)[2][2][4][2], const Unit& u, int wr, int wc, int fr, int fq) const {
        const int row0 = u.pm * BM + wr * 64 + fr; const int col0 = u.pn * HALF + wc * 32 + 8 * fq;
#pragma unroll
        for (int ai = 0; ai < 2; ++ai)
#pragma unroll
            for (int m = 0; m < 4; ++m) { bf16_t* rowp = O + (size_t)(row0 + ai * HALF + m * 16) * ldc + col0;
                float h[8];
#pragma unroll
                for (int n = 0; n < 2; ++n)
#pragma unroll
                    for (int j = 0; j < 4; ++j) { const float g = acc[ai][0][m][n][j], up = acc[ai][1][m][n][j];
                        h[n * 4 + j] = g * __builtin_amdgcn_rcpf(1.0f + __expf(-g)) * up; }
                u32x4 w; w.x = cvt_pk_bf16(h[0], h[1]); w.y = cvt_pk_bf16(h[2], h[3]); w.z = cvt_pk_bf16(h[4], h[5]); w.w = cvt_pk_bf16(h[6], h[7]);
                *(u32x4*)rowp = w; }
    }
};
struct EpiResid {
    static constexpr bool PERM = false, AFTER_DRAIN = false;
    const float* base; float* Z; int ldc; float alpha, beta;
    __device__ __forceinline__ void operator()(const f32x4 (&acc)[2][2][4][2], const Unit& u, int wr, int wc, int fr, int fq) const {
        const int row0 = u.pm * BM + wr * 64 + fr, col0 = u.pn * BM + wc * 32 + 4 * fq;
#pragma unroll
        for (int ai = 0; ai < 2; ++ai)
#pragma unroll
            for (int m = 0; m < 4; ++m) { const size_t off = (size_t)(row0 + ai * HALF + m * 16) * ldc + col0;
#pragma unroll
                for (int bj = 0; bj < 2; ++bj)
#pragma unroll
                    for (int n = 0; n < 2; ++n) { const f32x4 bs = *(const f32x4*)(base + off + bj * HALF + n * 16);
                        *(f32x4*)(Z + off + bj * HALF + n * 16) = bs * alpha + acc[ai][bj][m][n] * beta; } }
    }
};
}
constexpr int BATCH = 2, T = 4096, D = 2048, DEPTH = 4, M = BATCH * T;
constexpr int FF = 5504, NGU = 2 * FF;
constexpr int NIN = 5664, NINP = 5888;
constexpr int GH = 4, GK = 96, GV = 192, GDK = 384, GDV = 768, GR = 16, GC = 64, NCH = T / GC;
constexpr int DH = 6, DE = 128, DD = 768;
constexpr int CC = 512, CK = 31;
constexpr int PC_GQ = 0, PC_GK = 384, PC_GV = 768, PC_GG = 1536, PC_DQ = 2304, PC_DK = 3072, PC_DV = 3840, PC_CVAL = 4608, PC_CGATE = 5120, PC_RF = 5632, PC_RB = 5648;
constexpr float LN_EPS = 1e-5f;
constexpr float DN_ALPHA = 1.6817928305074290f;
constexpr size_t MiB = 1u << 20;
constexpr size_t WS_CTL = 0, CTL_ZERO_BYTES = 65536;
constexpr size_t WS_W = 1 * MiB;
constexpr size_t WO_GU1 = 0, WO_D1 = 43 * MiB, WO_IN = WO_D1 + 43 * MiB / 2, WO_OUT = WO_IN + 23 * MiB, WO_GU2 = WO_OUT + 8 * MiB, WO_D2 = WO_GU2 + 43 * MiB, W_LAYER = WO_D2 + 43 * MiB / 2;
static_assert(W_LAYER == 160 * MiB, "weights per layer");
constexpr size_t WS_XF = WS_W + W_LAYER;
constexpr size_t WS_Z = WS_XF + 64 * MiB;
constexpr size_t WS_XB = WS_Z + 64 * MiB;
constexpr size_t WS_CAT = WS_XB + 32 * MiB;
constexpr size_t WS_HP = WS_CAT + 32 * MiB;
constexpr size_t WS_U = WS_HP + 92 * MiB;
constexpr size_t WS_LAF = WS_U + 72 * MiB;
constexpr size_t WS_LAB = WS_LAF + 12 * MiB;
constexpr size_t WS_DEC = WS_LAB + 12 * MiB;
constexpr size_t WS_OP = WS_DEC + 1 * MiB;
constexpr size_t WS_LSE = WS_OP + 72 * MiB;
constexpr size_t WS_END = WS_LSE + 1 * MiB;
static_assert(WS_END <= 700 * MiB, "workspace");
constexpr int CW_BAR = 1024;
constexpr int RING_BYTES = 131072, LDS_BYTES = 147456, MISC_OFF = LDS_BYTES - 256;
constexpr int NWAVES = 8, NTHR = 512;

#define GAS __attribute__((address_space(1)))
#define LAS __attribute__((address_space(3)))
typedef unsigned short bf16;
typedef unsigned v4u __attribute__((ext_vector_type(4)));
typedef unsigned v2u __attribute__((ext_vector_type(2)));
typedef float f32x4 __attribute__((ext_vector_type(4)));
#define LDS_WAIT() asm volatile("s_waitcnt lgkmcnt(0)" ::: "memory")
typedef float f32x2_t __attribute__((ext_vector_type(2)));
typedef __bf16 bf16x2_t __attribute__((ext_vector_type(2)));
__device__ __forceinline__ unsigned pk2(float lo, float hi) { f32x2_t v = {lo, hi}; return __builtin_bit_cast(unsigned, __builtin_convertvector(v, bf16x2_t)); }
__device__ __forceinline__ unsigned f2bf(float f) { return (unsigned)__builtin_bit_cast(unsigned short, (__bf16)f); }
__device__ __forceinline__ float bflo(unsigned w) { return __builtin_bit_cast(float, w << 16); }
__device__ __forceinline__ float bfhi(unsigned w) { return __builtin_bit_cast(float, w & 0xffff0000u); }
__device__ __forceinline__ float bf2f(bf16 b) { return __builtin_bit_cast(float, ((unsigned)b) << 16); }
__device__ __forceinline__ float wave_sum(float v) {
#pragma unroll
    for (int o = 1; o < 64; o <<= 1) v += __shfl_xor(v, o);
    return v;
}
#define XB_TMO      128
#define XB_XCNT(j)  (256  + 64 * (j))
#define XB_XSUB(j)  (1280 + 64 * (j))
#define XB_XGEN(j)  (2304 + 64 * (j))
#define XB_TOP      3328
#define XB_TOPGEN   3392
#define XCD_BAR_WORDS 3456
#define XB_SPIN_CAP (1u << 18)

__device__ __forceinline__ unsigned xb_ld(unsigned* p)              { return __hip_atomic_load(p, __ATOMIC_RELAXED, __HIP_MEMORY_SCOPE_AGENT); }
__device__ __forceinline__ unsigned xb_add(unsigned* p, unsigned v) { return __hip_atomic_fetch_add(p, v, __ATOMIC_RELAXED, __HIP_MEMORY_SCOPE_AGENT); }
__device__ __forceinline__ unsigned xb_xcc_id() { return (unsigned)__builtin_amdgcn_s_getreg((3 << 11) | 20) & 0xFu; }
#define XB_SPIN(cond, bar) do { unsigned _sp = 0; while (cond) { __builtin_amdgcn_s_sleep(1); \
    if ((++_sp & 255u) == 0u) { if (xb_ld(&(bar)[XB_TMO])) break; if (_sp > XB_SPIN_CAP) { atomicAdd(&(bar)[XB_TMO], 1u); break; } } } } while (0)

struct XcdBarrier {
    unsigned* bar; unsigned x;
    volatile LAS unsigned* st;
};

__device__ __forceinline__ XcdBarrier xcd_barrier_post(unsigned* bar, volatile LAS unsigned* st) {
    XcdBarrier b; b.bar = bar; b.x = xb_xcc_id(); b.st = st;
    if (threadIdx.x == 0) (void)xb_add(&bar[XB_XCNT(b.x)], 1u);
    return b;
}
__device__ __forceinline__ void xcd_barrier_complete(unsigned* bar, unsigned x, unsigned& nloc, unsigned& nx) {
    const unsigned G = gridDim.x * gridDim.y * gridDim.z;
    unsigned sum, cnt, mine, sp = 0u;
    for (;;) {
        sum = 0u; cnt = 0u; mine = 0u;
#pragma unroll
        for (unsigned j = 0; j < 16; ++j) { const unsigned c = xb_ld(&bar[XB_XCNT(j)]); sum += c; cnt += (c > 0u) ? 1u : 0u; mine = (j == x) ? c : mine; }
        if (sum == G) break;
        __builtin_amdgcn_s_sleep(1);
        if ((++sp & 255u) == 0u) { if (xb_ld(&bar[XB_TMO])) break; if (sp > XB_SPIN_CAP) { atomicAdd(&bar[XB_TMO], 1u); break; } }
    }
    nloc = mine > 0u ? mine : 1u; nx = cnt > 0u ? cnt : 1u;
}

__device__ __forceinline__ void xcd_barrier(const XcdBarrier& b) {
    asm volatile("s_waitcnt vmcnt(0)" ::: "memory");
    __syncthreads();
    if (threadIdx.x == 0) {
        unsigned* bar = b.bar;
        __builtin_amdgcn_s_waitcnt(0);
        unsigned nloc = b.st[0], nx = b.st[1];
        if (nloc == 0u) { xcd_barrier_complete(bar, b.x, nloc, nx); b.st[0] = nloc; b.st[1] = nx; }
        const unsigned old = xb_add(&bar[XB_XSUB(b.x)], 1u);
        const unsigned gen = old / nloc;
        if (old + 1u == (gen + 1u) * nloc) {
            __builtin_amdgcn_fence(__ATOMIC_RELEASE, "agent");
            asm volatile("s_waitcnt vmcnt(0)" ::: "memory");
            const unsigned og = xb_add(&bar[XB_TOP], 1u);
            const unsigned tg = og / nx;
            if (og + 1u == (tg + 1u) * nx) xb_add(&bar[XB_TOPGEN], 1u);
            else XB_SPIN(xb_ld(&bar[XB_TOPGEN]) == tg, bar);
            __builtin_amdgcn_fence(__ATOMIC_ACQUIRE, "agent");
            xb_add(&bar[XB_XGEN(b.x)], 1u);
            asm volatile("s_waitcnt vmcnt(0)" ::: "memory");
        } else {
            XB_SPIN(xb_ld(&bar[XB_XGEN(b.x)]) == gen, bar);
            __builtin_amdgcn_fence(__ATOMIC_ACQUIRE, "agent");
            asm volatile("s_waitcnt vmcnt(0)" ::: "memory");
        }
    }
    __syncthreads();
}
__device__ __forceinline__ void tr_item(const float* W, int N, bf16* WT, int K, int k0, int n0, int drow0, LAS float* scr, int lane) {
    float tv[32];
    { const GAS float* wp = (const GAS float*)W + (size_t)(k0 + (lane >> 5)) * N + n0 + (lane & 31);
#pragma unroll
      for (int i = 0; i < 32; ++i) tv[i] = __builtin_nontemporal_load(wp + (size_t)(2 * i) * N); }
#pragma unroll
    for (int i = 0; i < 32; ++i) scr[(2 * i + (lane >> 5)) * 33 + (lane & 31)] = tv[i];
    LDS_WAIT(); asm volatile("" ::: "memory");
    const int c = lane & 7;
#pragma unroll
    for (int j = 0; j < 4; ++j) { const int n = (lane >> 3) + 8 * j; const LAS float* s = scr + (8 * c) * 33 + n;
        v4u o; o.x = pk2(s[0 * 33], s[1 * 33]); o.y = pk2(s[2 * 33], s[3 * 33]); o.z = pk2(s[4 * 33], s[5 * 33]); o.w = pk2(s[6 * 33], s[7 * 33]);
        *(GAS v4u*)(WT + (size_t)(drow0 + n) * K + k0 + 8 * c) = o; }
    LDS_WAIT(); asm volatile("" ::: "memory");
}
struct LayerW { const float *g1, *u1, *d1, *win, *wout, *g2, *u2, *d2; };
__device__ __forceinline__ void convert_phase(const LayerW& w, unsigned char* wsw, LAS unsigned char* lds, int bid, int G, int wave, int lane, int tid) {
    LAS float* scr = (LAS float*)(lds + wave * 16384);
    const int gw = bid * NWAVES + wave, NGW = G * NWAVES;
    constexpr int I_GU = (D / 64) * (FF / 32), I_DN = (FF / 64) * (D / 32), I_IN = (D / 64) * (NIN / 32), I_OUT = (D / 64) * (D / 32);
    constexpr int NITEMS = 6 * I_GU + I_IN + I_OUT; static_assert(I_GU == I_DN, "items");
    bf16* WGU1 = (bf16*)(wsw + WO_GU1); bf16* WD1 = (bf16*)(wsw + WO_D1); bf16* WIN = (bf16*)(wsw + WO_IN); bf16* WOUT = (bf16*)(wsw + WO_OUT); bf16* WGU2 = (bf16*)(wsw + WO_GU2); bf16* WD2 = (bf16*)(wsw + WO_D2);
    for (int it = gw; it < NITEMS; it += NGW) {
        int r = it;
        if (r < 4 * I_GU) {
            const int which = r / I_GU; r -= which * I_GU; const int nblk = FF / 32, kb = r / nblk, nb = r % nblk, n0 = 32 * nb;
            const float* W = which == 0 ? w.g1 : which == 1 ? w.u1 : which == 2 ? w.g2 : w.u2;
            tr_item(W, FF, which < 2 ? WGU1 : WGU2, D, 64 * kb, n0, 256 * (n0 / 128) + 128 * (which & 1) + (n0 % 128), scr, lane); continue; }
        r -= 4 * I_GU;
        if (r < 2 * I_DN) { const int which = r / I_DN; r -= which * I_DN; const int nblk = D / 32, kb = r / nblk, nb = r % nblk;
            tr_item(which ? w.d2 : w.d1, D, which ? WD2 : WD1, FF, 64 * kb, 32 * nb, 32 * nb, scr, lane); continue; }
        r -= 2 * I_DN;
        if (r < I_IN) { const int nblk = NIN / 32, kb = r / nblk, nb = r % nblk, n0 = 32 * nb;
            const int drow = n0 < 1536 ? n0 : (n0 == 1536 ? PC_RF : n0 - 32);
            tr_item(w.win, NIN, WIN, D, 64 * kb, n0, drow, scr, lane); continue; }
        r -= I_IN;
        { const int nblk = D / 32, kb = r / nblk, nb = r % nblk; tr_item(w.wout, D, WOUT, D, 64 * kb, 32 * nb, 32 * nb, scr, lane); }
    }
    { GAS v4u* p = (GAS v4u*)(WIN + (size_t)NIN * D); const int n16 = (NINP - NIN) * D / 8; const v4u z = {0u, 0u, 0u, 0u};
      for (int i = bid * NTHR + tid; i < n16; i += G * NTHR) p[i] = z; }
}
__device__ __forceinline__ void cast_phase(const float* x, bf16* XB, int bid, int G, int tid) {
    const GAS f32x4* s = (const GAS f32x4*)x; GAS v2u* d = (GAS v2u*)XB;
    for (int i = bid * NTHR + tid; i < M * D / 4; i += G * NTHR) { const f32x4 v = s[i]; v2u o; o.x = pk2(v.x, v.y); o.y = pk2(v.z, v.w); d[i] = o; }
}
__device__ __forceinline__ void ln_phase(const float* Z, const float* g, const float* b, float* XF, bf16* XB, int bid, int G, int wave, int lane) {
    const int gw = bid * NWAVES + wave, NGW = G * NWAVES;
    for (int m = gw; m < M; m += NGW) {
        const GAS f32x4* zr = (const GAS f32x4*)(Z + (size_t)m * D) + lane;
        f32x4 v[8]; float s = 0.f;
#pragma unroll
        for (int j = 0; j < 8; ++j) { v[j] = zr[64 * j]; s += (v[j].x + v[j].y) + (v[j].z + v[j].w); }
        const float mean = wave_sum(s) * (1.f / D); float s2 = 0.f;
#pragma unroll
        for (int j = 0; j < 8; ++j) { v[j] = v[j] - mean; s2 += (v[j].x * v[j].x + v[j].y * v[j].y) + (v[j].z * v[j].z + v[j].w * v[j].w); }
        const float rstd = 1.f / sqrtf(wave_sum(s2) * (1.f / D) + LN_EPS);
        GAS f32x4* xo = (GAS f32x4*)(XF + (size_t)m * D) + lane; GAS v2u* bo = (GAS v2u*)(XB + (size_t)m * D) + lane;
#pragma unroll
        for (int j = 0; j < 8; ++j) { const f32x4 gg = ((const GAS f32x4*)g)[lane + 64 * j], bb = ((const GAS f32x4*)b)[lane + 64 * j];
            const f32x4 o = v[j] * rstd * gg + bb; xo[64 * j] = o; v2u w; w.x = pk2(o.x, o.y); w.y = pk2(o.z, o.w); bo[64 * j] = w; }
    }
}

constexpr int DIL_PITCH = 136;
__device__ __forceinline__ void dil_item(int item, const bf16* PROJ, float* OP, float* LSE, LAS unsigned char* lds, int tid) {
    const int tt = item & 63; int r3 = item >> 6; const int br = r3 % 3; r3 /= 3; const int h = r3 % DH, b = r3 / DH;
    const int d = br == 0 ? 1 : (br == 1 ? 4 : 16), tpr = 64 / d, res = tt / tpr, i0 = (tt % tpr) * 64, L = T / d;
    LAS bf16* Ks = (LAS bf16*)lds; LAS bf16* Vs = Ks + 192 * DIL_PITCH;
    const bf16* base = PROJ + (size_t)b * T * NINP;
    for (int c = tid; c < 192 * 16; c += NTHR) { const int row = c >> 4, ch = c & 15, i = i0 - 64 + row;
        v4u kv = {0u, 0u, 0u, 0u}, vv = {0u, 0u, 0u, 0u};
        if (i >= 0 && i < L) { const bf16* rp = base + (size_t)(res + d * i) * NINP + h * DE + ch * 8; kv = *(const GAS v4u*)(rp + PC_DK); vv = *(const GAS v4u*)(rp + PC_DV); }
        *(LAS v4u*)(Ks + row * DIL_PITCH + ch * 8) = kv; *(LAS v4u*)(Vs + row * DIL_PITCH + ch * 8) = vv; }
    const int qi = tid >> 3, e = tid & 7, tq = res + d * (i0 + qi);
    float q[16];
    { const bf16* qp = base + (size_t)tq * NINP + PC_DQ + h * DE + e * 16; const v4u a = *(const GAS v4u*)qp, c = *(const GAS v4u*)(qp + 8);
      q[0] = bflo(a.x); q[1] = bfhi(a.x); q[2] = bflo(a.y); q[3] = bfhi(a.y); q[4] = bflo(a.z); q[5] = bfhi(a.z); q[6] = bflo(a.w); q[7] = bfhi(a.w);
      q[8] = bflo(c.x); q[9] = bfhi(c.x); q[10] = bflo(c.y); q[11] = bfhi(c.y); q[12] = bflo(c.z); q[13] = bfhi(c.z); q[14] = bflo(c.w); q[15] = bfhi(c.w); }
    __syncthreads();
    const float slope = exp2f(-8.0f * (float)(h + 1) / (float)DH) * (float)d, scale = 0.08838834764831845f;
    float mx = -1e30f, l = 0.f, acc[16];
#pragma unroll
    for (int x = 0; x < 16; ++x) acc[x] = 0.f;
    for (int jj = 0; jj <= 128; ++jj) {
        const int kr = qi + jj, i = i0 - 64 + kr;
        const LAS bf16* kp = Ks + kr * DIL_PITCH + e * 16; const v4u a = *(const LAS v4u*)kp, c = *(const LAS v4u*)(kp + 8);
        float dot = q[0] * bflo(a.x) + q[1] * bfhi(a.x) + q[2] * bflo(a.y) + q[3] * bfhi(a.y) + q[4] * bflo(a.z) + q[5] * bfhi(a.z) + q[6] * bflo(a.w) + q[7] * bfhi(a.w)
                  + q[8] * bflo(c.x) + q[9] * bfhi(c.x) + q[10] * bflo(c.y) + q[11] * bfhi(c.y) + q[12] * bflo(c.z) + q[13] * bfhi(c.z) + q[14] * bflo(c.w) + q[15] * bfhi(c.w);
        dot += __shfl_xor(dot, 1); dot += __shfl_xor(dot, 2); dot += __shfl_xor(dot, 4);
        if (i >= 0 && i < L) {
            const int aj = jj < 64 ? 64 - jj : jj - 64;
            const float s = dot * scale - slope * (float)aj, mn = fmaxf(mx, s), corr = __expf(mx - mn), p = __expf(s - mn);
            const LAS bf16* vp = Vs + kr * DIL_PITCH + e * 16; const v4u va = *(const LAS v4u*)vp, vc = *(const LAS v4u*)(vp + 8);
            l = l * corr + p; mx = mn;
            acc[0] = acc[0] * corr + p * bflo(va.x); acc[1] = acc[1] * corr + p * bfhi(va.x); acc[2] = acc[2] * corr + p * bflo(va.y); acc[3] = acc[3] * corr + p * bfhi(va.y);
            acc[4] = acc[4] * corr + p * bflo(va.z); acc[5] = acc[5] * corr + p * bfhi(va.z); acc[6] = acc[6] * corr + p * bflo(va.w); acc[7] = acc[7] * corr + p * bfhi(va.w);
            acc[8] = acc[8] * corr + p * bflo(vc.x); acc[9] = acc[9] * corr + p * bfhi(vc.x); acc[10] = acc[10] * corr + p * bflo(vc.y); acc[11] = acc[11] * corr + p * bfhi(vc.y);
            acc[12] = acc[12] * corr + p * bflo(vc.z); acc[13] = acc[13] * corr + p * bfhi(vc.z); acc[14] = acc[14] * corr + p * bflo(vc.w); acc[15] = acc[15] * corr + p * bfhi(vc.w);
        }
    }
    const float inv = 1.f / l; const size_t tok = (size_t)b * T + tq;
    GAS f32x4* op = (GAS f32x4*)(OP + ((size_t)br * M + tok) * DD + h * DE + e * 16);
#pragma unroll
    for (int x = 0; x < 4; ++x) op[x] = (f32x4){acc[4 * x] * inv, acc[4 * x + 1] * inv, acc[4 * x + 2] * inv, acc[4 * x + 3] * inv};
    if (e == 0) LSE[((size_t)br * M + tok) * DH + h] = mx + __logf(l);
    __syncthreads();
}
__device__ __forceinline__ void dil_merge_item(int item, const float* OP, const float* LSE, bf16* CAT, int tid) {
    for (int e = tid; e < 32 * (DD / 4); e += NTHR) { const int tk = e / (DD / 4), c4 = e % (DD / 4), col = 4 * c4, h = col / DE; const size_t tok = (size_t)item * 32 + tk;
        const float l0 = LSE[((size_t)0 * M + tok) * DH + h], l1 = LSE[((size_t)1 * M + tok) * DH + h], l2 = LSE[((size_t)2 * M + tok) * DH + h];
        const float mm = fmaxf(l0, fmaxf(l1, l2)), w0 = __expf(l0 - mm), w1 = __expf(l1 - mm), w2 = __expf(l2 - mm), inv = 1.f / (w0 + w1 + w2);
        const f32x4 a = *(const GAS f32x4*)(OP + ((size_t)0 * M + tok) * DD + col), bq = *(const GAS f32x4*)(OP + ((size_t)1 * M + tok) * DD + col), c = *(const GAS f32x4*)(OP + ((size_t)2 * M + tok) * DD + col);
        const f32x4 o = (a * w0 + bq * w1 + c * w2) * inv; v2u w; w.x = pk2(o.x, o.y); w.y = pk2(o.z, o.w);
        *(GAS v2u*)(CAT + tok * D + GDV + col) = w; }
}
__device__ __forceinline__ void conv_item(int item, const bf16* PROJ, const float* cw, const float* cb, const float* lg, const float* lb, bf16* CAT, LAS unsigned char* lds, int tid, int wave, int lane) {
    asm volatile("" : "+v"(tid)); lane = tid & 63; wave = __builtin_amdgcn_readfirstlane(tid >> 6);
    const int b = item / (T / 32), t0 = (item % (T / 32)) * 32;
    LAS float* us = (LAS float*)lds;
    for (int c = tid; c < 62 * 64; c += NTHR) { const int rr = c >> 6, ch = c & 63, t = t0 - 15 + rr; float u[8];
        if (t >= 0 && t < T) { const bf16* rp = PROJ + ((size_t)b * T + t) * NINP + ch * 8; const v4u a = *(const GAS v4u*)(rp + PC_CVAL), g = *(const GAS v4u*)(rp + PC_CGATE);
            const float av[8] = {bflo(a.x), bfhi(a.x), bflo(a.y), bfhi(a.y), bflo(a.z), bfhi(a.z), bflo(a.w), bfhi(a.w)}, gv[8] = {bflo(g.x), bfhi(g.x), bflo(g.y), bfhi(g.y), bflo(g.z), bfhi(g.z), bflo(g.w), bfhi(g.w)};
#pragma unroll
            for (int x = 0; x < 8; ++x) u[x] = av[x] / (1.f + __expf(-gv[x]));
        } else {
#pragma unroll
            for (int x = 0; x < 8; ++x) u[x] = 0.f; }
        *(LAS f32x4*)(us + rr * CC + ch * 8) = (f32x4){u[0], u[1], u[2], u[3]}; *(LAS f32x4*)(us + rr * CC + ch * 8 + 4) = (f32x4){u[4], u[5], u[6], u[7]}; }
    __syncthreads();
    float y[32];
    { const int c = tid; const float bias = cb[c];
#pragma unroll
      for (int tk = 0; tk < 32; ++tk) y[tk] = bias;
      for (int j = 0; j < CK; ++j) { const float wj = cw[j * CC + c];
#pragma unroll
          for (int tk = 0; tk < 32; ++tk) y[tk] += us[(tk + j) * CC + c] * wj; } }
    __syncthreads();
#pragma unroll
    for (int tk = 0; tk < 32; ++tk) us[tk * CC + tid] = y[tk];
    __syncthreads();
    for (int q = 0; q < 4; ++q) { const int tk = wave * 4 + q; const LAS float* yr = us + tk * CC + lane * 8; float v[8]; float s = 0.f;
#pragma unroll
        for (int x = 0; x < 8; ++x) { v[x] = yr[x]; s += v[x]; }
        const float mean = wave_sum(s) * (1.f / CC); float s2 = 0.f;
#pragma unroll
        for (int x = 0; x < 8; ++x) { v[x] -= mean; s2 += v[x] * v[x]; }
        const float rstd = 1.f / sqrtf(wave_sum(s2) * (1.f / CC) + LN_EPS); float o[8];
#pragma unroll
        for (int x = 0; x < 8; ++x) { const float z = v[x] * rstd * lg[lane * 8 + x] + lb[lane * 8 + x]; o[x] = z / (1.f + __expf(-z)); }
        v4u w; w.x = pk2(o[0], o[1]); w.y = pk2(o[2], o[3]); w.z = pk2(o[4], o[5]); w.w = pk2(o[6], o[7]);
        *(GAS v4u*)(CAT + ((size_t)b * T + t0 + tk) * D + GDV + DD + lane * 8) = w; }
    __syncthreads();
}
__device__ __forceinline__ void gla1_item(int item, const bf16* PROJ, const float* wf, const float* bf_, const float* wb, const float* bb_, float* U, float* LAF, float* LAB, float* DEC, LAS unsigned char* lds, int tid) {
    const int h = item & 3, n = (item >> 2) & 63, b = item >> 8; const size_t tok0 = (size_t)b * T + (size_t)n * GC;
    LAS float* kk = (LAS float*)lds; LAS float* vv = kk + 64 * 96; LAS float* cf = vv + 64 * 192; LAS float* cb = cf + 64 * 96; LAS float* rf = cb + 64 * 96; LAS float* rb = rf + 64 * 16;
    for (int c = tid; c < 64 * 12; c += NTHR) { const int row = c / 12, ch = c % 12; const v4u a = *(const GAS v4u*)(PROJ + (tok0 + row) * NINP + PC_GK + h * GK + ch * 8); LAS float* o = kk + row * 96 + ch * 8;
        o[0] = bflo(a.x); o[1] = bfhi(a.x); o[2] = bflo(a.y); o[3] = bfhi(a.y); o[4] = bflo(a.z); o[5] = bfhi(a.z); o[6] = bflo(a.w); o[7] = bfhi(a.w); }
    for (int c = tid; c < 64 * 24; c += NTHR) { const int row = c / 24, ch = c % 24; const v4u a = *(const GAS v4u*)(PROJ + (tok0 + row) * NINP + PC_GV + h * GV + ch * 8); LAS float* o = vv + row * 192 + ch * 8;
        o[0] = bflo(a.x); o[1] = bfhi(a.x); o[2] = bflo(a.y); o[3] = bfhi(a.y); o[4] = bflo(a.z); o[5] = bfhi(a.z); o[6] = bflo(a.w); o[7] = bfhi(a.w); }
    for (int c = tid; c < 64 * 32; c += NTHR) { const int row = c >> 5, x = c & 31; const float v = bf2f(PROJ[(tok0 + row) * NINP + PC_RF + x]); if (x < 16) rf[row * 16 + x] = v; else rb[row * 16 + x - 16] = v; }
    __syncthreads();
    for (int idx = tid; idx < 64 * 96; idx += NTHR) { const int c = idx / 96, k = idx % 96, hk = h * GK + k; float zf = bf_[hk], zb = bb_[hk];
#pragma unroll
        for (int r = 0; r < 16; ++r) { zf += rf[c * 16 + r] * wf[r * GDK + hk]; zb += rb[c * 16 + r] * wb[r * GDK + hk]; }
        cf[idx] = (fminf(zf, 0.f) - log1pf(expf(-fabsf(zf)))) * (1.f / 16.f); cb[idx] = (fminf(zb, 0.f) - log1pf(expf(-fabsf(zb)))) * (1.f / 16.f); }
    __syncthreads();
    if (tid < 96) { float run = 0.f;
#pragma unroll 4
        for (int c = 0; c < 64; ++c) { run += cf[c * 96 + tid]; cf[c * 96 + tid] = run; } }
    else if (tid < 192) { const int k = tid - 96; float run = 0.f;
#pragma unroll 4
        for (int c = 63; c >= 0; --c) { run += cb[c * 96 + k]; cb[c * 96 + k] = run; } }
    __syncthreads();
    for (int idx = tid; idx < 64 * 96; idx += NTHR) { const int c = idx / 96, k = idx % 96; LAF[(tok0 + c) * GDK + h * GK + k] = cf[idx]; LAB[(tok0 + c) * GDK + h * GK + k] = cb[idx]; }
    const size_t cid = ((size_t)(b * NCH + n) * GH + h) * 2;
    if (tid < 96) DEC[(cid + 0) * GK + tid] = __expf(cf[63 * 96 + tid]); else if (tid < 192) DEC[(cid + 1) * GK + tid - 96] = __expf(cb[tid - 96]);
    __syncthreads();
    if (tid < 96) { const float e = cf[63 * 96 + tid];
#pragma unroll 4
        for (int s = 0; s < 64; ++s) cf[s * 96 + tid] = kk[s * 96 + tid] * __expf(e - cf[s * 96 + tid]); }
    else if (tid < 192) { const int k = tid - 96; const float e = cb[k];
#pragma unroll 4
        for (int s = 63; s >= 0; --s) cb[s * 96 + k] = kk[s * 96 + k] * __expf(e - cb[s * 96 + k]); }
    __syncthreads();
#pragma unroll 1
    for (int j = 0; j < 36; ++j) { const int o = tid + NTHR * j, k = o / 192, v = o % 192; float af = 0.f, ab = 0.f;
#pragma unroll 8
        for (int s = 0; s < 64; ++s) { const float x = vv[s * 192 + v]; af += cf[s * 96 + k] * x; ab += cb[s * 96 + k] * x; }
        U[(cid + 0) * (GK * GV) + o] = af; U[(cid + 1) * (GK * GV) + o] = ab; }
    __syncthreads();
}
__device__ __forceinline__ void gla2_phase(float* U, const float* DEC, int bid, int G, int tid) {
    for (int e = bid * NTHR + tid; e < BATCH * GH * 2 * GK * GV; e += G * NTHR) {
        const int kv = e % (GK * GV); int r = e / (GK * GV); const int dir = r & 1; r >>= 1; const int h = r % GH, b = r / GH, k = kv / GV; float S = 0.f;
        for (int st = 0; st < NCH; ++st) { const int n = dir ? NCH - 1 - st : st; const size_t cid = ((size_t)(b * NCH + n) * GH + h) * 2 + dir;
            const float u = U[cid * (GK * GV) + kv], dc = DEC[cid * GK + k]; U[cid * (GK * GV) + kv] = S; S = dc * S + u; }
    }
}
__device__ __forceinline__ void gla3_item(int item, const bf16* PROJ, const float* U, const float* LAF, const float* LAB, const float* gn, bf16* CAT, LAS unsigned char* lds, int tid, int wave, int lane) {
    const int h = item & 3, n = (item >> 2) & 63, b = item >> 8; const size_t tok0 = (size_t)b * T + (size_t)n * GC;
    LAS float* qdT = (LAS float*)lds; LAS float* kiT = qdT + 96 * 64; LAS float* vv = kiT + 96 * 64; LAS float* attT = vv + 64 * 192; LAS float* obuf = qdT;
    for (int c = tid; c < 64 * 24; c += NTHR) { const int row = c / 24, ch = c % 24; const v4u a = *(const GAS v4u*)(PROJ + (tok0 + row) * NINP + PC_GV + h * GV + ch * 8); LAS float* o = vv + row * 192 + ch * 8;
        o[0] = bflo(a.x); o[1] = bfhi(a.x); o[2] = bflo(a.y); o[3] = bfhi(a.y); o[4] = bflo(a.z); o[5] = bfhi(a.z); o[6] = bflo(a.w); o[7] = bfhi(a.w); }
    const int v = tid % 192, cg = tid / 192;
    float acc[32];
#pragma unroll
    for (int i = 0; i < 32; ++i) acc[i] = 0.f;
    const size_t cid = ((size_t)(b * NCH + n) * GH + h) * 2;
    for (int dir = 0; dir < 2; ++dir) {
        const float* LA = dir ? LAB : LAF;
        for (int idx = tid; idx < 64 * 96; idx += NTHR) { const int c = idx / 96, k = idx % 96; const float bc = LA[(tok0 + c) * GDK + h * GK + k];
            const float qv = bf2f(PROJ[(tok0 + c) * NINP + PC_GQ + h * GK + k]), kv = bf2f(PROJ[(tok0 + c) * NINP + PC_GK + h * GK + k]);
            qdT[k * 64 + c] = qv * 0.10206207261596577f * __expf(bc); kiT[k * 64 + c] = kv * __expf(-bc); }
        __syncthreads();
        for (int j = 0; j < 8; ++j) { const int idx = tid + NTHR * j, s = idx >> 6, c = idx & 63; float a = 0.f;
            if (dir ? (s >= c) : (s <= c)) { for (int k = 0; k < 96; ++k) a += qdT[k * 64 + c] * kiT[k * 64 + s]; }
            attT[s * 64 + c] = a; }
        __syncthreads();
        if (tid < 384) {
            for (int s = 0; s < 64; ++s) { const float x = vv[s * 192 + v]; const LAS f32x4* ap = (const LAS f32x4*)(attT + s * 64 + 32 * cg);
#pragma unroll
                for (int i = 0; i < 8; ++i) { const f32x4 a = ap[i]; acc[4 * i] += a.x * x; acc[4 * i + 1] += a.y * x; acc[4 * i + 2] += a.z * x; acc[4 * i + 3] += a.w * x; } }
            const float* Sp = U + (cid + dir) * (GK * GV) + v;
            for (int k = 0; k < 96; ++k) { const float x = Sp[k * GV]; const LAS f32x4* qp = (const LAS f32x4*)(qdT + k * 64 + 32 * cg);
#pragma unroll
                for (int i = 0; i < 8; ++i) { const f32x4 a = qp[i]; acc[4 * i] += a.x * x; acc[4 * i + 1] += a.y * x; acc[4 * i + 2] += a.z * x; acc[4 * i + 3] += a.w * x; } }
        }
        __syncthreads();
    }
    if (tid < 384) {
#pragma unroll
        for (int i = 0; i < 32; ++i) obuf[(32 * cg + i) * 192 + v] = acc[i]; }
    __syncthreads();
    for (int cc = 0; cc < 8; ++cc) { const int c = wave * 8 + cc; float x[3], ss = 0.f;
#pragma unroll
        for (int j = 0; j < 3; ++j) { x[j] = obuf[c * 192 + lane + 64 * j]; ss += x[j] * x[j]; }
        const float r = 1.f / sqrtf(wave_sum(ss) * (1.f / GV) + LN_EPS);
#pragma unroll
        for (int j = 0; j < 3; ++j) { const int vc = lane + 64 * j; const float g = bf2f(PROJ[(tok0 + c) * NINP + PC_GG + h * GV + vc]);
            const float o = x[j] * r * gn[h * GV + vc] * (g / (1.f + __expf(-g))); CAT[(tok0 + c) * D + h * GV + vc] = (bf16)f2bf(o); } }
    __syncthreads();
}
typedef short bf16x8 __attribute__((ext_vector_type(8)));
#define MFMA16(a, b, c) __builtin_amdgcn_mfma_f32_16x16x32_bf16((a), (b), (c), 0, 0, 0)
__device__ __forceinline__ unsigned cvtpk(float lo, float hi) { return pk2(lo, hi); }
__device__ __forceinline__ bf16x8 frag_from(v2u lo, v2u hi) { v4u t = {lo.x, lo.y, hi.x, hi.y}; return __builtin_bit_cast(bf16x8, t); }

constexpr int DK_PITCH = 136, DV_PITCH = 264;
constexpr int DIL_VT_OFF = 256 * DK_PITCH * 2;
static_assert(DIL_VT_OFF + 128 * DV_PITCH * 2 <= 140000, "dil LDS");
__device__ __forceinline__ void dil_item2(int item, const bf16* PROJ, bf16* OPB, float* LSE, LAS unsigned char* lds, int tid) {
    asm volatile("" : "+v"(tid));
    const int tt = item & 31; int r3 = item >> 5; const int br = r3 % 3; r3 /= 3; const int h = r3 % DH, b = r3 / DH;
    const int d = br == 0 ? 1 : (br == 1 ? 4 : 16), tpr = 32 / d, res = tt / tpr, i0 = (tt % tpr) * 128, L = T / d;
    LAS bf16* Ks = (LAS bf16*)lds; LAS bf16* VTs = (LAS bf16*)(lds + DIL_VT_OFF);
    const bf16* base = PROJ + (size_t)b * T * NINP;
    const int lane = tid & 63, w = tid >> 6, ql = lane & 15, g = lane >> 4;
    const int tq = res + d * (i0 + 16 * w + ql);
    bf16x8 qf[4];
#pragma unroll
    for (int ks = 0; ks < 4; ++ks) qf[ks] = *(const GAS bf16x8*)(base + (size_t)tq * NINP + PC_DQ + h * DE + 32 * ks + 8 * g);
#pragma unroll 2
    for (int c = tid; c < 256 * 16; c += NTHR) { const int row = c >> 4, ch = c & 15, i = i0 - 64 + row;
        v4u kv = {0u, 0u, 0u, 0u}, vv = {0u, 0u, 0u, 0u};
        if (i >= 0 && i < L) { const bf16* rp = base + (size_t)(res + d * i) * NINP + h * DE + ch * 8; kv = *(const GAS v4u*)(rp + PC_DK); vv = *(const GAS v4u*)(rp + PC_DV); }
        *(LAS v4u*)(Ks + row * DK_PITCH + ch * 8) = kv;
        LAS bf16* vp = VTs + (ch * 8) * DV_PITCH + row;
        vp[0 * DV_PITCH] = (bf16)(vv.x & 0xffffu); vp[1 * DV_PITCH] = (bf16)(vv.x >> 16); vp[2 * DV_PITCH] = (bf16)(vv.y & 0xffffu); vp[3 * DV_PITCH] = (bf16)(vv.y >> 16);
        vp[4 * DV_PITCH] = (bf16)(vv.z & 0xffffu); vp[5 * DV_PITCH] = (bf16)(vv.z >> 16); vp[6 * DV_PITCH] = (bf16)(vv.w & 0xffffu); vp[7 * DV_PITCH] = (bf16)(vv.w >> 16); }
    __syncthreads();
    const float slope = exp2f(-8.0f * (float)(h + 1) / (float)DH) * (float)d, scale = 0.08838834764831845f;
    f32x4 st[9]; float mx = -1e30f;
#pragma unroll
    for (int kt = 0; kt < 9; ++kt) { f32x4 acc = {0.f, 0.f, 0.f, 0.f};
#pragma unroll
        for (int ks = 0; ks < 4; ++ks) { const bf16x8 a = *(const LAS bf16x8*)(Ks + (16 * w + 16 * kt + ql) * DK_PITCH + 32 * ks + 8 * g); acc = MFMA16(a, qf[ks], acc); }
#pragma unroll
        for (int e = 0; e < 4; ++e) { const int j = 16 * kt + 4 * g + e - 64 - ql, ik = i0 + 16 * w + ql + j; const int aj = j < 0 ? -j : j;
            const bool ok = (aj <= 64) && (ik >= 0) && (ik < L); const float s = ok ? acc[e] * scale - slope * (float)aj : -1e30f; acc[e] = s; mx = fmaxf(mx, s); }
        st[kt] = acc; }
    mx = fmaxf(mx, __shfl_xor(mx, 16)); mx = fmaxf(mx, __shfl_xor(mx, 32));
    float l = 0.f;
#pragma unroll
    for (int kt = 0; kt < 9; ++kt)
#pragma unroll
        for (int e = 0; e < 4; ++e) { const float p = __expf(st[kt][e] - mx); st[kt][e] = p; l += p; }
    l += __shfl_xor(l, 16); l += __shfl_xor(l, 32);
    bf16x8 pf[5];
#pragma unroll
    for (int t = 0; t < 4; ++t) { v4u u; u.x = cvtpk(st[2 * t][0], st[2 * t][1]); u.y = cvtpk(st[2 * t][2], st[2 * t][3]); u.z = cvtpk(st[2 * t + 1][0], st[2 * t + 1][1]); u.w = cvtpk(st[2 * t + 1][2], st[2 * t + 1][3]); pf[t] = __builtin_bit_cast(bf16x8, u); }
    { v4u u; u.x = cvtpk(st[8][0], st[8][1]); u.y = cvtpk(st[8][2], st[8][3]); u.z = 0u; u.w = 0u; pf[4] = __builtin_bit_cast(bf16x8, u); }
    const float inv = 1.f / l; const size_t tok = (size_t)b * T + tq;
    bf16* orow = OPB + ((size_t)br * M + tok) * DD + h * DE + 4 * g;
#pragma unroll
    for (int dt = 0; dt < 8; ++dt) { f32x4 o = {0.f, 0.f, 0.f, 0.f}; const LAS bf16* vrow = VTs + (16 * dt + ql) * DV_PITCH + 16 * w + 4 * g;
#pragma unroll
        for (int t = 0; t < 5; ++t) { const v2u lo = *(const LAS v2u*)(vrow + 32 * t), hi = *(const LAS v2u*)(vrow + 32 * t + (t < 4 ? 16 : 0)); o = MFMA16(frag_from(lo, hi), pf[t], o); }
        v2u wv; wv.x = cvtpk(o[0] * inv, o[1] * inv); wv.y = cvtpk(o[2] * inv, o[3] * inv); *(GAS v2u*)(orow + 16 * dt) = wv; }
    if (g == 0) LSE[((size_t)br * M + tok) * DH + h] = mx + __logf(l);
    __syncthreads();
}
__device__ __forceinline__ void dil_merge_item2(int item, const bf16* OPB, const float* LSE, bf16* CAT, int tid) {
    asm volatile("" : "+v"(tid));
    for (int e = tid; e < 32 * (DD / 4); e += NTHR) { const int tk = e / (DD / 4), c4 = e % (DD / 4), col = 4 * c4, h = col / DE; const size_t tok = (size_t)item * 32 + tk;
        const float l0 = LSE[((size_t)0 * M + tok) * DH + h], l1 = LSE[((size_t)1 * M + tok) * DH + h], l2 = LSE[((size_t)2 * M + tok) * DH + h];
        const float mm = fmaxf(l0, fmaxf(l1, l2)), w0 = __expf(l0 - mm), w1 = __expf(l1 - mm), w2 = __expf(l2 - mm), inv = 1.f / (w0 + w1 + w2);
        const v2u a = *(const GAS v2u*)(OPB + ((size_t)0 * M + tok) * DD + col), bq = *(const GAS v2u*)(OPB + ((size_t)1 * M + tok) * DD + col), c = *(const GAS v2u*)(OPB + ((size_t)2 * M + tok) * DD + col);
        const float o0 = (bflo(a.x) * w0 + bflo(bq.x) * w1 + bflo(c.x) * w2) * inv, o1 = (bfhi(a.x) * w0 + bfhi(bq.x) * w1 + bfhi(c.x) * w2) * inv;
        const float o2 = (bflo(a.y) * w0 + bflo(bq.y) * w1 + bflo(c.y) * w2) * inv, o3 = (bfhi(a.y) * w0 + bfhi(bq.y) * w1 + bfhi(c.y) * w2) * inv;
        v2u wv; wv.x = pk2(o0, o1); wv.y = pk2(o2, o3); *(GAS v2u*)(CAT + tok * D + GDV + col) = wv; }
}

constexpr int G_KT = 72, G_QP = 104;
__device__ __forceinline__ void vt_scatter(const bf16* PROJ, size_t tok0, int h, LAS bf16* VT, int tid) {
    for (int c = tid; c < 64 * 24; c += NTHR) { const int row = c / 24, ch = c % 24; const v4u a = *(const GAS v4u*)(PROJ + (tok0 + row) * NINP + PC_GV + h * GV + ch * 8); LAS bf16* vp = VT + (ch * 8) * G_KT + row;
        vp[0 * G_KT] = (bf16)(a.x & 0xffffu); vp[1 * G_KT] = (bf16)(a.x >> 16); vp[2 * G_KT] = (bf16)(a.y & 0xffffu); vp[3 * G_KT] = (bf16)(a.y >> 16);
        vp[4 * G_KT] = (bf16)(a.z & 0xffffu); vp[5 * G_KT] = (bf16)(a.z >> 16); vp[6 * G_KT] = (bf16)(a.w & 0xffffu); vp[7 * G_KT] = (bf16)(a.w >> 16); }
}
__device__ __forceinline__ void gla1_item2(int item, const bf16* PROJ, const float* wf, const float* bf_, const float* wb, const float* bb_, bf16* UT, float* LAF, float* LAB, float* DEC, LAS unsigned char* lds, int tid) {
    asm volatile("" : "+v"(tid));
    const int h = item & 3, n = (item >> 2) & 63, b = item >> 8; const size_t tok0 = (size_t)b * T + (size_t)n * GC;
    LAS float* cf = (LAS float*)lds; LAS float* cb = cf + 64 * 96; LAS float* rf = cb + 64 * 96; LAS float* rb = rf + 64 * 16;
    LAS bf16* KEF = (LAS bf16*)(lds + 57344); LAS bf16* KEB = KEF + 96 * G_KT; LAS bf16* VT = KEB + 96 * G_KT;
    for (int c = tid; c < 64 * 32; c += NTHR) { const int row = c >> 5, x = c & 31; const float v = bf2f(PROJ[(tok0 + row) * NINP + PC_RF + x]); if (x < 16) rf[row * 16 + x] = v; else rb[row * 16 + x - 16] = v; }
    vt_scatter(PROJ, tok0, h, VT, tid);
    __syncthreads();
    for (int idx = tid; idx < 64 * 96; idx += NTHR) { const int c = idx / 96, k = idx % 96, hk = h * GK + k; float zf = bf_[hk], zb = bb_[hk];
#pragma unroll
        for (int r = 0; r < 16; ++r) { zf += rf[c * 16 + r] * wf[r * GDK + hk]; zb += rb[c * 16 + r] * wb[r * GDK + hk]; }
        cf[idx] = (fminf(zf, 0.f) - __logf(1.f + __expf(-fabsf(zf)))) * (1.f / 16.f); cb[idx] = (fminf(zb, 0.f) - __logf(1.f + __expf(-fabsf(zb)))) * (1.f / 16.f); }
    __syncthreads();
    if (tid < 96) { float run = 0.f;
#pragma unroll 4
        for (int c = 0; c < 64; ++c) { run += cf[c * 96 + tid]; cf[c * 96 + tid] = run; } }
    else if (tid < 192) { const int k = tid - 96; float run = 0.f;
#pragma unroll 4
        for (int c = 63; c >= 0; --c) { run += cb[c * 96 + k]; cb[c * 96 + k] = run; } }
    __syncthreads();
    const size_t cid = ((size_t)(b * NCH + n) * GH + h) * 2;
    if (tid < 96) DEC[(cid + 0) * GK + tid] = __expf(cf[63 * 96 + tid]); else if (tid < 192) DEC[(cid + 1) * GK + tid - 96] = __expf(cb[tid - 96]);
    for (int idx = tid; idx < 64 * 96; idx += NTHR) { const int s = idx / 96, k = idx % 96; const float f = cf[idx], bk = cb[idx];
        LAF[(tok0 + s) * GDK + h * GK + k] = f; LAB[(tok0 + s) * GDK + h * GK + k] = bk;
        const float kv = bf2f(PROJ[(tok0 + s) * NINP + PC_GK + h * GK + k]);
        KEF[k * G_KT + s] = (bf16)f2bf(kv * __expf(cf[63 * 96 + k] - f)); KEB[k * G_KT + s] = (bf16)f2bf(kv * __expf(cb[k] - bk)); }
    __syncthreads();
    const int lane = tid & 63, w = tid >> 6, ql = lane & 15, g = lane >> 4;
#pragma unroll 1
    for (int ti = 0; ti < 9; ++ti) { const int idx = 9 * w + ti, kt = idx / 12, vt = idx % 12;
        const bf16x8 v0 = *(const LAS bf16x8*)(VT + (16 * vt + ql) * G_KT + 8 * g), v1 = *(const LAS bf16x8*)(VT + (16 * vt + ql) * G_KT + 32 + 8 * g);
#pragma unroll
        for (int dir = 0; dir < 2; ++dir) { const LAS bf16* KE = dir ? KEB : KEF; f32x4 acc = {0.f, 0.f, 0.f, 0.f};
            acc = MFMA16(*(const LAS bf16x8*)(KE + (16 * kt + ql) * G_KT + 8 * g), v0, acc); acc = MFMA16(*(const LAS bf16x8*)(KE + (16 * kt + ql) * G_KT + 32 + 8 * g), v1, acc);
            v2u wv; wv.x = cvtpk(acc[0], acc[1]); wv.y = cvtpk(acc[2], acc[3]);
            *(GAS v2u*)(UT + (cid + dir) * (GK * GV) + (size_t)(16 * vt + ql) * GK + 16 * kt + 4 * g) = wv; } }
    __syncthreads();
}
__device__ __forceinline__ void gla2_phase2(bf16* UT, const float* DEC, LAS unsigned char* lds, int bid, int G, int tid) {
    constexpr int NQ = GK * GV / 4, WPS = NQ / NTHR;
    static_assert(NQ % NTHR == 0, "scan units");
    LAS float* dl = (LAS float*)lds;
    for (int u = bid; u < BATCH * GH * 2 * WPS; u += G) {
        const int sl = u / WPS, q = (u % WPS) * NTHR + tid, dir = sl & 1, h = (sl >> 1) % GH, b = (sl >> 1) / GH, k0 = (q % (GK / 4)) * 4;
        for (int i = tid; i < NCH * GK; i += NTHR) { const int st = i / GK, k = i % GK, n = dir ? NCH - 1 - st : st; dl[i] = DEC[(((size_t)(b * NCH + n) * GH + h) * 2 + dir) * GK + k]; }
        constexpr long CSTR = (long)GH * 2 * NQ; const long step = dir ? -CSTR : CSTR;
        GAS v2u* p0 = (GAS v2u*)UT + ((((size_t)(b * NCH + (dir ? NCH - 1 : 0)) * GH + h) * 2 + dir) * NQ + (size_t)q);
        v2u wv[NCH]; GAS v2u* p = p0;
#pragma unroll
        for (int st = 0; st < NCH; ++st) { wv[st] = *p; p += step; asm volatile("" : "+v"(p)); }
        __syncthreads();
        float S0 = 0.f, S1 = 0.f, S2 = 0.f, S3 = 0.f; p = p0;
#pragma unroll
        for (int st = 0; st < NCH; ++st) { const f32x4 dc = *(const LAS f32x4*)(dl + st * GK + k0);
            v2u o; o.x = pk2(S0, S1); o.y = pk2(S2, S3); *p = o; p += step; asm volatile("" : "+v"(p));
            S0 = dc.x * S0 + bflo(wv[st].x); S1 = dc.y * S1 + bfhi(wv[st].x); S2 = dc.z * S2 + bflo(wv[st].y); S3 = dc.w * S3 + bfhi(wv[st].y); }
        __syncthreads();
    }
}
__device__ __forceinline__ void gla3_item2(int item, const bf16* PROJ, const bf16* UT, const float* LAF, const float* LAB, const float* gn, bf16* CAT, LAS unsigned char* lds, int tid) {
    asm volatile("" : "+v"(tid));
    const int h = item & 3, n = (item >> 2) & 63, b = item >> 8; const size_t tok0 = (size_t)b * T + (size_t)n * GC;
    LAS bf16* QD = (LAS bf16*)lds; LAS bf16* KI = QD + 64 * G_QP; LAS bf16* VT = KI + 64 * G_QP; LAS bf16* ST = VT + 192 * G_KT; LAS float* SS = (LAS float*)(ST + 192 * G_QP);
    const int lane = tid & 63, w = tid >> 6, ql = lane & 15, g = lane >> 4, ct = w & 3, vh = w >> 2;
    vt_scatter(PROJ, tok0, h, VT, tid);
    f32x4 acc_o[6];
#pragma unroll
    for (int vt = 0; vt < 6; ++vt) acc_o[vt] = (f32x4){0.f, 0.f, 0.f, 0.f};
    const size_t cid = ((size_t)(b * NCH + n) * GH + h) * 2;
#pragma unroll 1
    for (int dir = 0; dir < 2; ++dir) {
        const float* LA = dir ? LAB : LAF;
        for (int idx = tid; idx < 64 * 96; idx += NTHR) { const int c = idx / 96, k = idx % 96; const float bc = LA[(tok0 + c) * GDK + h * GK + k];
            const float qv = bf2f(PROJ[(tok0 + c) * NINP + PC_GQ + h * GK + k]), kv = bf2f(PROJ[(tok0 + c) * NINP + PC_GK + h * GK + k]);
            QD[c * G_QP + k] = (bf16)f2bf(qv * 0.10206207261596577f * __expf(bc)); KI[c * G_QP + k] = (bf16)f2bf(kv * __expf(-bc)); }
        for (int c2 = tid; c2 < 192 * 12; c2 += NTHR) { const int row = c2 / 12, ch = c2 % 12; *(LAS v4u*)(ST + row * G_QP + ch * 8) = *(const GAS v4u*)(UT + (cid + dir) * (GK * GV) + (size_t)row * GK + ch * 8); }
        __syncthreads();
        bf16x8 qf[3];
#pragma unroll
        for (int ks = 0; ks < 3; ++ks) qf[ks] = *(const LAS bf16x8*)(QD + (16 * ct + ql) * G_QP + 32 * ks + 8 * g);
        f32x4 at[4];
#pragma unroll
        for (int s4 = 0; s4 < 4; ++s4) { f32x4 a = {0.f, 0.f, 0.f, 0.f};
#pragma unroll
            for (int ks = 0; ks < 3; ++ks) a = MFMA16(*(const LAS bf16x8*)(KI + (16 * s4 + ql) * G_QP + 32 * ks + 8 * g), qf[ks], a);
#pragma unroll
            for (int e = 0; e < 4; ++e) { const int s = 16 * s4 + 4 * g + e, c = 16 * ct + ql; const bool keep = dir ? (s >= c) : (s <= c); a[e] = keep ? a[e] : 0.f; }
            at[s4] = a; }
        bf16x8 pf[2];
#pragma unroll
        for (int t = 0; t < 2; ++t) { v4u u; u.x = cvtpk(at[2 * t][0], at[2 * t][1]); u.y = cvtpk(at[2 * t][2], at[2 * t][3]); u.z = cvtpk(at[2 * t + 1][0], at[2 * t + 1][1]); u.w = cvtpk(at[2 * t + 1][2], at[2 * t + 1][3]); pf[t] = __builtin_bit_cast(bf16x8, u); }
#pragma unroll
        for (int vt = 0; vt < 6; ++vt) { const int vrow = 96 * vh + 16 * vt + ql; f32x4 o = acc_o[vt];
#pragma unroll
            for (int t = 0; t < 2; ++t) { const v2u lo = *(const LAS v2u*)(VT + vrow * G_KT + 32 * t + 4 * g), hi = *(const LAS v2u*)(VT + vrow * G_KT + 32 * t + 16 + 4 * g); o = MFMA16(frag_from(lo, hi), pf[t], o); }
#pragma unroll
            for (int ks = 0; ks < 3; ++ks) o = MFMA16(*(const LAS bf16x8*)(ST + vrow * G_QP + 32 * ks + 8 * g), qf[ks], o);
            acc_o[vt] = o; }
        __syncthreads();
    }
    float ss = 0.f;
#pragma unroll
    for (int vt = 0; vt < 6; ++vt) ss += (acc_o[vt][0] * acc_o[vt][0] + acc_o[vt][1] * acc_o[vt][1]) + (acc_o[vt][2] * acc_o[vt][2] + acc_o[vt][3] * acc_o[vt][3]);
    ss += __shfl_xor(ss, 16); ss += __shfl_xor(ss, 32);
    if (g == 0) SS[vh * 64 + 16 * ct + ql] = ss;
    __syncthreads();
    const float r = 1.f / sqrtf((SS[16 * ct + ql] + SS[64 + 16 * ct + ql]) * (1.f / GV) + LN_EPS);
    const size_t tok = tok0 + 16 * ct + ql;
#pragma unroll
    for (int vt = 0; vt < 6; ++vt) { const int v0 = h * GV + 96 * vh + 16 * vt + 4 * g; const v2u gq = *(const GAS v2u*)(PROJ + tok * NINP + PC_GG + v0); const f32x4 gnv = *(const GAS f32x4*)(gn + v0);
        const float g0 = bflo(gq.x), g1 = bfhi(gq.x), g2 = bflo(gq.y), g3 = bfhi(gq.y);
        const float o0 = acc_o[vt][0] * r * gnv.x * (g0 / (1.f + __expf(-g0))), o1 = acc_o[vt][1] * r * gnv.y * (g1 / (1.f + __expf(-g1)));
        const float o2 = acc_o[vt][2] * r * gnv.z * (g2 / (1.f + __expf(-g2))), o3 = acc_o[vt][3] * r * gnv.w * (g3 / (1.f + __expf(-g3)));
        v2u wv; wv.x = cvtpk(o0, o1); wv.y = cvtpk(o2, o3); *(GAS v2u*)(CAT + tok * D + v0) = wv; }
    __syncthreads();
}
typedef __attribute__((address_space(4))) const unsigned long long kargq;
__device__ __forceinline__ kargq* karg_base() { kargq* kp = (kargq*)__builtin_amdgcn_kernarg_segment_ptr(); asm volatile("" : "+s"(kp)); return kp; }
__device__ __forceinline__ const float* karg_in(int i) { return (const float*)karg_base()[i]; }
__device__ __forceinline__ float* karg_out() { return (float*)karg_base()[24]; }
__device__ __forceinline__ unsigned char* karg_ws() { return (unsigned char*)karg_base()[25]; }
struct Args { const float* in[24]; float* out; unsigned char* ws; };
#ifndef STOP_AFTER
#define STOP_AFTER 1000000
#endif
__global__ void __launch_bounds__(NTHR, 2) fwd_kernel(Args a) {
    extern __shared__ __attribute__((aligned(16))) unsigned char lds_raw[];
    LAS unsigned char* lds = (LAS unsigned char*)lds_raw;
    volatile LAS unsigned* MISC = (volatile LAS unsigned*)(lds + MISC_OFF);
    const int tid0 = threadIdx.x;
#define IDS() int tid = threadIdx.x; asm volatile("" : "+v"(tid)); const int lane = tid & 63, wave = __builtin_amdgcn_readfirstlane(tid >> 6); int G = gridDim.x, bid = blockIdx.x; asm volatile("" : "+s"(G), "+s"(bid)); (void)lane; (void)wave
    if (tid0 < 32) MISC[tid0] = 0u;
    __syncthreads();
    XcdBarrier bar = xcd_barrier_post((unsigned*)(karg_ws() + WS_CTL) + CW_BAR, MISC + 8);
    int phase_no = 0;
#define GRID_BAR() do { XcdBarrier b2_ = bar; asm volatile("" : "+s"(b2_.bar)); xcd_barrier(b2_); if (++phase_no > STOP_AFTER) return; } while (0)

#define XF ((float*)(karg_ws() + WS_XF))
#define Z ((float*)(karg_ws() + WS_Z))
#define XB ((bf16*)(karg_ws() + WS_XB))
#define CAT ((bf16*)(karg_ws() + WS_CAT))
#define HB ((bf16*)(karg_ws() + WS_HP))
#define PROJ ((bf16*)(karg_ws() + WS_HP))
#define UT ((bf16*)(karg_ws() + WS_U))
#define LAF ((float*)(karg_ws() + WS_LAF))
#define LAB ((float*)(karg_ws() + WS_LAB))
#define DEC ((float*)(karg_ws() + WS_DEC))
#define OPB ((bf16*)(karg_ws() + WS_OP))
#define LSE ((float*)(karg_ws() + WS_LSE))
#define wsw (karg_ws() + WS_W)
#define WGU1 ((bf16*)(wsw + WO_GU1))
#define WD1 ((bf16*)(wsw + WO_D1))
#define WIN ((bf16*)(wsw + WO_IN))
#define WOUT ((bf16*)(wsw + WO_OUT))
#define WGU2 ((bf16*)(wsw + WO_GU2))
#define WD2 ((bf16*)(wsw + WO_D2))
    for (int l = 0; l < DEPTH; ++l) {
        { IDS(); LayerW w; const size_t so = (size_t)l * D * FF;
          w.g1 = karg_in(1) + so; w.u1 = karg_in(2) + so; w.d1 = karg_in(3) + so; w.win = karg_in(6) + (size_t)l * D * NIN; w.wout = karg_in(16) + (size_t)l * D * D;
          w.g2 = karg_in(19) + so; w.u2 = karg_in(20) + so; w.d2 = karg_in(21) + so;
          convert_phase(w, wsw, lds, bid, G, wave, lane, tid);
          if (l == 0) cast_phase(karg_in(0), XB, bid, G, tid); }
        GRID_BAR();
        { IDS(); pg8::Gemm g{XB, WGU1, M, NGU, D}; pg8::StaticOrder S; S.init(M, NGU, G, bid); pg8::EpiSwiglu E{HB, FF};
          pg8::gemm_phase<pg8::EpiSwiglu, pg8::StaticOrder, true, true>(lds, g, S, E); }
        GRID_BAR();
        { IDS(); pg8::Gemm g{HB, WD1, M, D, FF}; pg8::StaticOrder S; S.init(M, D, G, bid); pg8::EpiResid E{l == 0 ? karg_in(0) : XF, Z, D, DN_ALPHA, 0.5f};
          pg8::gemm_phase<pg8::EpiResid, pg8::StaticOrder, true, true>(lds, g, S, E); }
        GRID_BAR();
        { IDS(); ln_phase(Z, karg_in(4) + (size_t)l * D, karg_in(5) + (size_t)l * D, XF, XB, bid, G, wave, lane); }
        GRID_BAR();
        { IDS(); pg8::Gemm g{XB, WIN, M, NINP, D}; pg8::StaticOrder S; S.init(M, NINP, G, bid); pg8::EpiBf16 E{PROJ, NINP};
          pg8::gemm_phase<pg8::EpiBf16, pg8::StaticOrder, true, true>(lds, g, S, E); }
        GRID_BAR();
        { IDS(); constexpr int N_DIL = BATCH * DH * 3 * 32, N_G1 = BATCH * NCH * GH, N_CV = BATCH * (T / 32);
          for (int it = bid; it < N_DIL + N_G1 + N_CV; it += G) {
              if (it < N_DIL) dil_item2(it, PROJ, OPB, LSE, lds, tid);
              else if (it < N_DIL + N_G1) gla1_item2(it - N_DIL, PROJ, karg_in(7) + (size_t)l * GR * GDK, karg_in(8) + (size_t)l * GDK, karg_in(9) + (size_t)l * GR * GDK, karg_in(10) + (size_t)l * GDK, UT, LAF, LAB, DEC, lds, tid);
              else conv_item(it - N_DIL - N_G1, PROJ, karg_in(12) + (size_t)l * CK * CC, karg_in(13) + (size_t)l * CC, karg_in(14) + (size_t)l * CC, karg_in(15) + (size_t)l * CC, CAT, lds, tid, wave, lane);
          } }
        GRID_BAR();
        { IDS(); gla2_phase2(UT, DEC, lds, bid, G, tid); }
        GRID_BAR();
        { IDS(); constexpr int N_G3 = BATCH * NCH * GH, N_MG = M / 32;
          for (int it = bid; it < N_G3 + N_MG; it += G) {
              if (it < N_G3) gla3_item2(it, PROJ, UT, LAF, LAB, karg_in(11) + (size_t)l * GDV, CAT, lds, tid);
              else dil_merge_item2(it - N_G3, OPB, LSE, CAT, tid);
          } }
        GRID_BAR();
        { IDS(); pg8::Gemm g{CAT, WOUT, M, D, D}; pg8::StaticOrder S; S.init(M, D, G, bid); pg8::EpiResid E{XF, Z, D, DN_ALPHA, 1.0f};
          pg8::gemm_phase<pg8::EpiResid, pg8::StaticOrder, true, true>(lds, g, S, E); }
        GRID_BAR();
        { IDS(); ln_phase(Z, karg_in(17) + (size_t)l * D, karg_in(18) + (size_t)l * D, XF, XB, bid, G, wave, lane); }
        GRID_BAR();
        { IDS(); pg8::Gemm g{XB, WGU2, M, NGU, D}; pg8::StaticOrder S; S.init(M, NGU, G, bid); pg8::EpiSwiglu E{HB, FF};
          pg8::gemm_phase<pg8::EpiSwiglu, pg8::StaticOrder, true, true>(lds, g, S, E); }
        GRID_BAR();
        { IDS(); pg8::Gemm g{HB, WD2, M, D, FF}; pg8::StaticOrder S; S.init(M, D, G, bid); pg8::EpiResid E{XF, Z, D, DN_ALPHA, 0.5f};
          pg8::gemm_phase<pg8::EpiResid, pg8::StaticOrder, true, true>(lds, g, S, E); }
        GRID_BAR();
        { IDS(); ln_phase(Z, karg_in(22) + (size_t)l * D, karg_in(23) + (size_t)l * D, l == DEPTH - 1 ? karg_out() : XF, XB, bid, G, wave, lane); }
        GRID_BAR();
    }
}

extern "C" void kernel_launch(void* const* d_in, const int* in_sizes, int n_in, void* d_out, int out_size, void* d_ws, size_t ws_size, hipStream_t stream) {
    static int grid = 0;
    if (grid == 0) {
        if (n_in != 24 || in_sizes[0] != M * D || out_size != M * D || ws_size < WS_END) { fprintf(stderr, "kernel_launch: unexpected problem shape / workspace (n_in %d, ws %zu < %zu); nothing launched\n", n_in, ws_size, (size_t)WS_END); grid = -1; return; }
        int dev = 0, cus = 0, per_cu = 0;
        if (hipGetDevice(&dev) != hipSuccess || hipDeviceGetAttribute(&cus, hipDeviceAttributeMultiprocessorCount, dev) != hipSuccess) { grid = -1; return; }
        if (hipFuncSetAttribute((const void*)fwd_kernel, hipFuncAttributeMaxDynamicSharedMemorySize, LDS_BYTES) != hipSuccess) { fprintf(stderr, "kernel_launch: hipFuncSetAttribute failed\n"); grid = -1; return; }
        if (hipOccupancyMaxActiveBlocksPerMultiprocessor(&per_cu, (const void*)fwd_kernel, NTHR, LDS_BYTES) != hipSuccess || per_cu < 1) fprintf(stderr, "kernel_launch: occupancy query reports %d\n", per_cu);
        (void)hipGetLastError();
        grid = cus;
    }
    if (grid < 0) return;
    if (hipMemsetAsync((char*)d_ws + WS_CTL, 0, CTL_ZERO_BYTES, stream) != hipSuccess) return;
    Args a{};
    for (int i = 0; i < 24; ++i) a.in[i] = (const float*)d_in[i];
    a.out = (float*)d_out; a.ws = (unsigned char*)d_ws;
    hipLaunchKernelGGL(fwd_kernel, dim3(grid), dim3(NTHR), LDS_BYTES, stream, a);
}
```
